# Optimizing an MI355X kernel written in HIP

```python
import math
import jax
import jax.numpy as jnp
from jax import lax
import numpy as np

D_MODEL = 2048
BATCH = 4
SEQ = 2048
DEPTH = 2

CTX_LEN = 256
GRID_W = 64
D_MIX = D_MODEL
ATT_WIDTH = D_MIX // 2
POOL_WIDTH = D_MIX // 4
CONV_WIDTH = D_MIX - ATT_WIDTH - POOL_WIDTH
ATT_HEADS = 8
ATT_HD = ATT_WIDTH // (2 * ATT_HEADS)
ATT_VD = 2 * ATT_HD
POOL_WINDOWS = (2, 4, 8, 16)
POOL_GROUPS = len(POOL_WINDOWS)
POOL_GD = POOL_WIDTH // POOL_GROUPS
CONV_K = 31
Q_BLOCK = 128
ROPE_BASE = 10000.0
EPS = 1e-6
SPLITS = (ATT_WIDTH, 2 * ATT_WIDTH, 3 * ATT_WIDTH, 4 * ATT_WIDTH,
          4 * ATT_WIDTH + POOL_WIDTH, 4 * ATT_WIDTH + 2 * POOL_WIDTH,
          4 * ATT_WIDTH + 2 * POOL_WIDTH + CONV_WIDTH,
          4 * ATT_WIDTH + 2 * POOL_WIDTH + 2 * CONV_WIDTH)
N_IN = 4 * ATT_WIDTH + 2 * POOL_WIDTH + 3 * CONV_WIDTH

kernel_name = "hybrid_pool_diffattn_conformer_dit_block"


def _rmsnorm(x, g):
    xf = x.astype(jnp.float32)
    y = xf * lax.rsqrt(jnp.mean(xf * xf, axis=-1, keepdims=True) + EPS)
    return (y * g.astype(jnp.float32)).astype(x.dtype)


def _layernorm(x, g, b):
    xf = x.astype(jnp.float32)
    mu = jnp.mean(xf, axis=-1, keepdims=True)
    var = jnp.mean(jnp.square(xf - mu), axis=-1, keepdims=True)
    y = (xf - mu) * lax.rsqrt(var + EPS) * g.astype(jnp.float32) + b.astype(jnp.float32)
    return y.astype(x.dtype)


def _heads_qk(t):
    return t.reshape(t.shape[0], t.shape[1], ATT_HEADS, 2, ATT_HD)


def _heads_v(t):
    return t.reshape(t.shape[0], t.shape[1], ATT_HEADS, ATT_VD)


def _axial_rope(t, row, col):
    n_freq = ATT_HD // 4
    inv_freq = ROPE_BASE ** (-jnp.arange(n_freq, dtype=jnp.float32) / n_freq)

    def rot(u, pos):
        ang = pos.astype(jnp.float32)[:, None] * inv_freq[None, :]
        cos = jnp.concatenate([jnp.cos(ang)] * 2, axis=-1)[None, :, None, None, :]
        sin = jnp.concatenate([jnp.sin(ang)] * 2, axis=-1)[None, :, None, None, :]
        u1, u2 = jnp.split(u, 2, axis=-1)
        rh = jnp.concatenate([-u2, u1], axis=-1)
        return (u.astype(jnp.float32) * cos + rh.astype(jnp.float32) * sin).astype(u.dtype)

    t_row, t_col = jnp.split(t, 2, axis=-1)
    return jnp.concatenate([rot(t_row, row), rot(t_col, col)], axis=-1)


def _diff_attention(q, k, v, lam):
    B, Lq = q.shape[0], q.shape[1]
    nb = Lq // Q_BLOCK
    qb = jnp.moveaxis(q.reshape(B, nb, Q_BLOCK, ATT_HEADS, 2, ATT_HD), 1, 0)
    scale = ATT_HD ** -0.5

    def block(qq):
        s = jnp.einsum('bqhcd,bkhcd->bhcqk', qq, k).astype(jnp.float32) * scale
        p = jax.nn.softmax(s, axis=-1)
        a = p[:, :, 0] - lam * p[:, :, 1]
        return jnp.einsum('bhqk,bkhe->bqhe', a.astype(v.dtype), v)

    o = lax.map(block, qb)
    return jnp.moveaxis(o, 0, 1).reshape(B, Lq, ATT_HEADS, ATT_VD)


def _multiscale_pool(u, w_pool, pool_scale):
    B, L, _ = u.shape
    ug = u.reshape(B, L, POOL_GROUPS, POOL_GD)
    cs = jnp.concatenate([jnp.zeros((B, 1, POOL_GROUPS, POOL_GD), jnp.float32),
                          jnp.cumsum(ug.astype(jnp.float32), axis=1)], axis=1)
    t = jnp.arange(L, dtype=jnp.int32)[:, None]
    halfw = jnp.array(POOL_WINDOWS, dtype=jnp.int32)[None, :] // 2
    lo = jnp.clip(t - halfw, 0, L)
    hi = jnp.clip(t + halfw, 0, L)
    gi = jnp.arange(POOL_GROUPS, dtype=jnp.int32)[None, :]
    win_sum = cs[:, hi, gi] - cs[:, lo, gi]
    mean = win_sum / (hi - lo).astype(jnp.float32)[None, :, :, None]
    d = (mean - ug.astype(jnp.float32)).astype(u.dtype)
    y = jnp.einsum('blgc,gcd->blgd', d, w_pool) * pool_scale.reshape(POOL_GROUPS, POOL_GD)
    return y.reshape(B, L, POOL_WIDTH)


def _conformer_conv(a, b, w_dw, b_dw, ln_g, ln_b, w_pw2):
    u = a * jax.nn.sigmoid(b)
    y = lax.conv_general_dilated(u, w_dw[:, None, :].astype(u.dtype), window_strides=(1,),
                                 padding=[(CONV_K // 2, CONV_K // 2)],
                                 dimension_numbers=('NWC', 'WIO', 'NWC'),
                                 feature_group_count=CONV_WIDTH) + b_dw
    y = jax.nn.silu(_layernorm(y, ln_g, ln_b))
    return y @ w_pw2


def _mix(q, k, v, g_att, u_pool, g_pool, a_conv, b_conv, g_conv, lam, lam_init,
         subln_g, w_pool, pool_scale, w_dw, b_dw, ln_g, ln_b, w_pw2, w_out):
    B, L = q.shape[0], q.shape[1]
    o = _diff_attention(q, k, v, lam)
    y_att = (_rmsnorm(o, subln_g) * (1.0 - lam_init)).reshape(B, L, ATT_WIDTH)
    y_pool = _multiscale_pool(u_pool, w_pool, pool_scale)
    y_conv = _conformer_conv(a_conv, b_conv, w_dw, b_dw, ln_g, ln_b, w_pw2)
    y = jnp.concatenate([y_att * jax.nn.silu(g_att),
                         y_pool * jax.nn.silu(g_pool),
                         y_conv * jax.nn.silu(g_conv)], axis=-1)
    return y @ w_out


def setup_inputs(seed: int = 0) -> dict:
    key = jax.random.key(seed)
    ks = jax.random.split(key, 24)
    f32 = jnp.float32
    n = lambda k, s, sc: jax.random.normal(k, s, f32) * sc
    return {
        "x": n(ks[0], (BATCH, SEQ, D_MODEL), 1.0),
        "c": n(ks[1], (BATCH, D_MODEL), 1.0),
        "ctx": n(ks[2], (BATCH, CTX_LEN, D_MODEL), 1.0),
        "c_ctx": n(ks[3], (D_MODEL,), 1.0),
        "w_mod": n(ks[4], (DEPTH, D_MODEL, 3 * D_MODEL), 0.5 * D_MODEL ** -0.5),
        "b_mod": n(ks[5], (DEPTH, 3 * D_MODEL), 0.02),
        "norm_g": 1.0 + n(ks[6], (DEPTH, D_MODEL), 0.05),
        "w_in": n(ks[7], (DEPTH, D_MODEL, N_IN), D_MODEL ** -0.5),
        "lambda_q1": n(ks[8], (DEPTH, ATT_HD), 0.1),
        "lambda_k1": n(ks[9], (DEPTH, ATT_HD), 0.1),
        "lambda_q2": n(ks[10], (DEPTH, ATT_HD), 0.1),
        "lambda_k2": n(ks[11], (DEPTH, ATT_HD), 0.1),
        "subln_g": 1.0 + n(ks[12], (DEPTH, ATT_VD), 0.05),
        "w_pool": n(ks[13], (DEPTH, POOL_GROUPS, POOL_GD, POOL_GD), POOL_GD ** -0.5),
        "pool_scale": 1.0 + n(ks[14], (DEPTH, POOL_WIDTH), 0.05),
        "w_dw": n(ks[15], (DEPTH, CONV_K, CONV_WIDTH), CONV_K ** -0.5),
        "b_dw": n(ks[16], (DEPTH, CONV_WIDTH), 0.02),
        "conv_ln_g": 1.0 + n(ks[17], (DEPTH, CONV_WIDTH), 0.05),
        "conv_ln_b": n(ks[18], (DEPTH, CONV_WIDTH), 0.02),
        "w_pw2": n(ks[19], (DEPTH, CONV_WIDTH, CONV_WIDTH), CONV_WIDTH ** -0.5),
        "w_out": n(ks[20], (DEPTH, D_MIX, D_MODEL), D_MIX ** -0.5),
        "final_g": 1.0 + n(ks[21], (D_MODEL,), 0.05),
    }


def reference(x, c, ctx, c_ctx, w_mod, b_mod, norm_g, w_in, lambda_q1, lambda_k1, lambda_q2, lambda_k2,
              subln_g, w_pool, pool_scale, w_dw, b_dw, conv_ln_g, conv_ln_b, w_pw2, w_out, final_g):
    B, L, _ = x.shape
    rows = L // GRID_W
    row = jnp.repeat(jnp.arange(rows, dtype=jnp.int32), GRID_W)
    col = jnp.tile(jnp.arange(GRID_W, dtype=jnp.int32), rows)
    s_lat = jax.nn.silu(c)
    s_ctx = jax.nn.silu(c_ctx)
    for l in range(DEPTH):
        last = l == DEPTH - 1
        lam_init = 0.8 - 0.6 * math.exp(-0.3 * l)
        lam = (jnp.exp(jnp.sum(lambda_q1[l].astype(jnp.float32) * lambda_k1[l].astype(jnp.float32)))
               - jnp.exp(jnp.sum(lambda_q2[l].astype(jnp.float32) * lambda_k2[l].astype(jnp.float32)))
               + lam_init)
        shift, scale, gate = jnp.split((s_lat @ w_mod[l] + b_mod[l])[:, None, :], 3, axis=-1)
        shift_c, scale_c, gate_c = jnp.split(s_ctx @ w_mod[l] + b_mod[l], 3, axis=-1)
        hx = _rmsnorm(x, norm_g[l]) * (1.0 + scale) + shift
        hc = _rmsnorm(ctx, norm_g[l]) * (1.0 + scale_c) + shift_c

        q, k, v, g_att, u_pool, g_pool, a_conv, b_conv, g_conv = jnp.split(hx @ w_in[l], SPLITS, axis=-1)
        q = _axial_rope(_heads_qk(q), row, col)
        k = _axial_rope(_heads_qk(k), row, col)
        v = _heads_v(v)
        if last:
            k_c, v_c = jnp.split(hc @ w_in[l][:, ATT_WIDTH:3 * ATT_WIDTH], 2, axis=-1)
        else:
            (q_c, k_c, v_c, g_att_c, u_pool_c, g_pool_c,
             a_conv_c, b_conv_c, g_conv_c) = jnp.split(hc @ w_in[l], SPLITS, axis=-1)
        k_c = _heads_qk(k_c)
        v_c = _heads_v(v_c)

        lw = (subln_g[l], w_pool[l], pool_scale[l], w_dw[l], b_dw[l],
              conv_ln_g[l], conv_ln_b[l], w_pw2[l], w_out[l])
        y = _mix(q, jnp.concatenate([k_c, k], axis=1), jnp.concatenate([v_c, v], axis=1),
                 g_att, u_pool, g_pool, a_conv, b_conv, g_conv, lam, lam_init, *lw)
        if not last:
            y_c = _mix(_heads_qk(q_c), k_c, v_c, g_att_c, u_pool_c, g_pool_c,
                       a_conv_c, b_conv_c, g_conv_c, lam, lam_init, *lw)
            ctx = ctx + gate_c * y_c
        x = x + gate * y
    return _rmsnorm(x, final_g)
```

```cpp
#include <hip/hip_runtime.h>
#include <cstdint>
#include <cstdio>
#include <cmath>

constexpr int DM = 2048, BATCH = 4, SEQ = 2048, DEPTH = 2, CTX = 256;
constexpr int N_IN = 6656, N_MOD = 6144, HEADS = 8;
constexpr int TPB = CTX + SEQ;
constexpr int M_TOT = BATCH * TPB;
constexpr float EPS = 1e-6f;
constexpr int C_Q = 0, C_K = 1024, C_V = 2048, C_GA = 3072, C_UP = 4096, C_GP = 4608, C_CA = 5120, C_CB = 5632, C_GC = 6144;

typedef unsigned short bf16_t;
__device__ __forceinline__ float bf2f(bf16_t v) { return __uint_as_float(((unsigned)v) << 16); }
__device__ __forceinline__ bf16_t f2bf(float f) { unsigned u = __float_as_uint(f); return (bf16_t)((u + 0x7fffu + ((u >> 16) & 1u)) >> 16); }
__device__ __forceinline__ float silu_f(float v) { return v / (1.f + __expf(-v)); }
__device__ __forceinline__ float sigm_f(float v) { return 1.f / (1.f + __expf(-v)); }
__device__ __forceinline__ float wave_sum(float v) {
#pragma unroll
    for (int o = 1; o < 64; o <<= 1) v += __shfl_xor(v, o);
    return v;
}

constexpr size_t MiB = 1u << 20;
constexpr size_t WS_CTL = 0;
constexpr size_t WS_MOD = 1 * MiB;
constexpr size_t WS_WIN = 2 * MiB;
constexpr size_t WS_WOUT = 54 * MiB;
constexpr size_t WS_WPW2 = 70 * MiB;
constexpr size_t WS_WPOOL = 71 * MiB;
constexpr size_t WS_CTXRES = 72 * MiB;
constexpr size_t WS_H = 80 * MiB;
constexpr size_t WS_P = 116 * MiB;
constexpr size_t WS_YMIX = 234 * MiB;
constexpr size_t WS_OC = 270 * MiB;
constexpr size_t WS_END = 342 * MiB;

__global__ void k_transpose(const float* __restrict__ W, bf16_t* __restrict__ WT, int K, int N) {
    __shared__ float t[32][33];
    W += (size_t)blockIdx.z * K * N; WT += (size_t)blockIdx.z * K * N;
    const int n0 = blockIdx.x * 32, k0 = blockIdx.y * 32, tx = threadIdx.x & 31, ty = threadIdx.x >> 5;
    for (int i = ty; i < 32; i += 8) t[i][tx] = W[(size_t)(k0 + i) * N + n0 + tx];
    __syncthreads();
    for (int i = ty; i < 32; i += 8) WT[(size_t)(n0 + i) * K + k0 + tx] = f2bf(t[tx][i]);
}

__global__ void k_mod(const float* __restrict__ c, const float* __restrict__ c_ctx, const float* __restrict__ w_mod, const float* __restrict__ b_mod,
                      const float* __restrict__ lq1, const float* __restrict__ lk1, const float* __restrict__ lq2, const float* __restrict__ lk2, float* __restrict__ MOD) {
    __shared__ float s[5][2048];
    __shared__ float red[4][5][64];
    const int l = blockIdx.y, tid = threadIdx.x, n = blockIdx.x * 64 + (tid & 63), kq = tid >> 6;
    for (int i = tid; i < 5 * 2048; i += 256) { const int r = i >> 11, k = i & 2047; const float v = r < 4 ? c[r * 2048 + k] : c_ctx[k]; s[r][k] = v / (1.f + expf(-v)); }
    __syncthreads();
    float acc[5] = {0.f, 0.f, 0.f, 0.f, 0.f};
    const float* W = w_mod + (size_t)l * DM * N_MOD;
    for (int k = kq * 512; k < kq * 512 + 512; ++k) { const float w = W[(size_t)k * N_MOD + n];
#pragma unroll
        for (int r = 0; r < 5; ++r) acc[r] += s[r][k] * w; }
#pragma unroll
    for (int r = 0; r < 5; ++r) red[kq][r][tid & 63] = acc[r];
    __syncthreads();
    if (kq == 0) {
#pragma unroll
        for (int r = 0; r < 5; ++r) MOD[((size_t)l * 5 + r) * N_MOD + n] = red[0][r][tid] + red[1][r][tid] + red[2][r][tid] + red[3][r][tid] + b_mod[l * N_MOD + n];
    }
    if (blockIdx.x == 0 && tid == 0) {
        float a = 0.f, b = 0.f;
        for (int i = 0; i < 64; ++i) { a += lq1[l * 64 + i] * lk1[l * 64 + i]; b += lq2[l * 64 + i] * lk2[l * 64 + i]; }
        const float lam_init = 0.8f - 0.6f * expf(-0.3f * (float)l);
        MOD[2 * 5 * N_MOD + l] = expf(a) - expf(b) + lam_init;
    }
}

__global__ void k_norm(const float* __restrict__ xsrc, const float* __restrict__ csrc, const float* __restrict__ g, const float* __restrict__ MODl, bf16_t* __restrict__ H) {
    const int row = blockIdx.x * 4 + (threadIdx.x >> 6), lane = threadIdx.x & 63;
    const int b = row / TPB, t = row % TPB; const bool isctx = t < CTX;
    const float* src = isctx ? csrc + ((size_t)b * CTX + t) * DM : xsrc + ((size_t)b * SEQ + (t - CTX)) * DM;
    const float* mod = MODl + (size_t)(isctx ? 4 : b) * N_MOD;
    float4 v[8]; float ss = 0.f;
#pragma unroll
    for (int j = 0; j < 8; ++j) { v[j] = ((const float4*)src)[lane + 64 * j]; ss += v[j].x * v[j].x + v[j].y * v[j].y + v[j].z * v[j].z + v[j].w * v[j].w; }
    ss = wave_sum(ss);
    const float rstd = rsqrtf(ss * (1.f / DM) + EPS);
#pragma unroll
    for (int j = 0; j < 8; ++j) { const int col = (lane + 64 * j) * 4;
        const float4 gg = *(const float4*)(g + col), sh = *(const float4*)(mod + col), sc = *(const float4*)(mod + 2048 + col);
        const float o0 = v[j].x * rstd * gg.x * (1.f + sc.x) + sh.x, o1 = v[j].y * rstd * gg.y * (1.f + sc.y) + sh.y;
        const float o2 = v[j].z * rstd * gg.z * (1.f + sc.z) + sh.z, o3 = v[j].w * rstd * gg.w * (1.f + sc.w) + sh.w;
        uint2 w; w.x = (unsigned)f2bf(o0) | ((unsigned)f2bf(o1) << 16); w.y = (unsigned)f2bf(o2) | ((unsigned)f2bf(o3) << 16);
        *(uint2*)(H + (size_t)row * DM + col) = w; }
}

struct EpiArgs { bf16_t* P; const float* MODl; const float* xin; const float* cin; float* xout; float* cout; int last; int pad; };
template <int MODE> __global__ __launch_bounds__(256) void k_gemm_naive(const bf16_t* __restrict__ A, const bf16_t* __restrict__ Bt, int M, int N, int K, EpiArgs e) {
    __shared__ float As[16][65], Bs[16][65];
    const int tid = threadIdx.x, tx = tid & 15, ty = tid >> 4, m0 = blockIdx.y * 64, n0 = blockIdx.x * 64;
    float acc[4][4];
#pragma unroll
    for (int i = 0; i < 4; ++i)
#pragma unroll
        for (int j = 0; j < 4; ++j) acc[i][j] = 0.f;
    const int lr = tid >> 2, lk = (tid & 3) * 4;
    for (int k0 = 0; k0 < K; k0 += 16) {
        const uint2 a = *(const uint2*)(A + (size_t)(m0 + lr) * K + k0 + lk), b = *(const uint2*)(Bt + (size_t)(n0 + lr) * K + k0 + lk);
        As[lk + 0][lr] = bf2f((bf16_t)(a.x & 0xffff)); As[lk + 1][lr] = bf2f((bf16_t)(a.x >> 16)); As[lk + 2][lr] = bf2f((bf16_t)(a.y & 0xffff)); As[lk + 3][lr] = bf2f((bf16_t)(a.y >> 16));
        Bs[lk + 0][lr] = bf2f((bf16_t)(b.x & 0xffff)); Bs[lk + 1][lr] = bf2f((bf16_t)(b.x >> 16)); Bs[lk + 2][lr] = bf2f((bf16_t)(b.y & 0xffff)); Bs[lk + 3][lr] = bf2f((bf16_t)(b.y >> 16));
        __syncthreads();
#pragma unroll
        for (int kk = 0; kk < 16; ++kk) { float av[4], bv[4];
#pragma unroll
            for (int i = 0; i < 4; ++i) { av[i] = As[kk][ty * 4 + i]; bv[i] = Bs[kk][tx + 16 * i]; }
#pragma unroll
            for (int i = 0; i < 4; ++i)
#pragma unroll
                for (int j = 0; j < 4; ++j) acc[i][j] += av[i] * bv[j]; }
        __syncthreads();
    }
#pragma unroll
    for (int i = 0; i < 4; ++i) {
        const int r = m0 + ty * 4 + i, b = r / TPB, t = r % TPB; const bool lat = t >= CTX; const int tl = t - CTX;
        if (MODE == 0) {
#pragma unroll
            for (int jp = 0; jp < 2; ++jp) {
                const int cA = n0 + tx + 32 * jp, cB = cA + 16; float vA = acc[i][2 * jp], vB = acc[i][2 * jp + 1];
                if (cA < 2048 && lat) {
                    const int d = cA & 63; const float pos = (d < 32) ? (float)(tl / 64) : (float)(tl % 64);
                    const float inv = powf(10000.f, -(float)tx / 16.f), ang = pos * inv, cs = cosf(ang), sn = sinf(ang);
                    const float oA = vA * cs - vB * sn, oB = vB * cs + vA * sn; vA = oA; vB = oB;
                }
                e.P[(size_t)r * N + cA] = f2bf(vA); e.P[(size_t)r * N + cB] = f2bf(vB);
            }
        } else {
            if (!lat && e.last) continue;
#pragma unroll
            for (int j = 0; j < 4; ++j) { const int col = n0 + tx + 16 * j;
                const float gate = e.MODl[(size_t)(lat ? b : 4) * N_MOD + 4096 + col];
                const size_t off = lat ? ((size_t)b * SEQ + tl) * DM + col : ((size_t)b * CTX + t) * DM + col;
                const float old = lat ? e.xin[off] : e.cin[off];
                (lat ? e.xout : e.cout)[off] = old + gate * acc[i][j]; }
        }
    }
}

__global__ __launch_bounds__(64) void k_attn_naive(const bf16_t* __restrict__ P, float* __restrict__ OC, int is_ctx) {
    __shared__ float Ks[64][64]; __shared__ float Vs[64][128];
    const int qb = blockIdx.x, hc = blockIdx.y, b = blockIdx.z, h = hc >> 1, comp = hc & 1, lane = threadIdx.x;
    const int qrow = b * TPB + (is_ctx ? 0 : CTX) + qb * 64 + lane, nk = is_ctx ? CTX : TPB, krow0 = b * TPB;
    float q[64], o[128]; float m = -1e30f, l = 0.f;
    { const bf16_t* qp = P + (size_t)qrow * N_IN + C_Q + h * 128 + comp * 64;
#pragma unroll
      for (int d = 0; d < 64; ++d) q[d] = bf2f(qp[d]) * 0.125f; }
#pragma unroll
    for (int e2 = 0; e2 < 128; ++e2) o[e2] = 0.f;
    for (int kt = 0; kt < nk; kt += 64) {
        for (int i = 0; i < 64; ++i) { const bf16_t* rp = P + (size_t)(krow0 + kt + i) * N_IN;
            Ks[i][lane] = bf2f(rp[C_K + h * 128 + comp * 64 + lane]); Vs[i][lane] = bf2f(rp[C_V + h * 128 + lane]); Vs[i][lane + 64] = bf2f(rp[C_V + h * 128 + 64 + lane]); }
        __syncthreads();
        for (int j = 0; j < 64; ++j) {
            float s = 0.f;
#pragma unroll
            for (int d = 0; d < 64; ++d) s += q[d] * Ks[j][d];
            if (s > m) { const float al = __expf(m - s); l *= al;
#pragma unroll
                for (int e2 = 0; e2 < 128; ++e2) o[e2] *= al;
                m = s; }
            const float p = __expf(s - m); l += p;
#pragma unroll
            for (int e2 = 0; e2 < 128; ++e2) o[e2] += p * Vs[j][e2];
        }
        __syncthreads();
    }
    const float il = 1.f / l; float* op = OC + ((size_t)comp * M_TOT + qrow) * 1024 + h * 128;
#pragma unroll
    for (int e2 = 0; e2 < 128; ++e2) op[e2] = o[e2] * il;
}

struct MixArgs { const bf16_t* P; const float* OC; bf16_t* Y; const float* MOD; const float* subln_g; const float* w_pool; const float* pool_scale; const float* w_dw; const float* b_dw;
                 const float* ln_g; const float* ln_b; const float* w_pw2; int layer; int pad; };
__global__ __launch_bounds__(256) void k_mix_naive(MixArgs a) {
    __shared__ float dsh[8][512]; __shared__ float ysh[8][512];
    const int tid = threadIdx.x, lane = tid & 63, wv = tid >> 6, r0 = blockIdx.x * 8;
    const int b = r0 / TPB, t0 = r0 % TPB; const bool isctx = t0 < CTX;
    if (isctx && a.layer == DEPTH - 1) return;
    const int seq0 = b * TPB + (isctx ? 0 : CTX), L = isctx ? CTX : SEQ, tl0 = isctx ? t0 : t0 - CTX;
    const float lam = a.MOD[2 * 5 * N_MOD + a.layer], lam_init = 0.8f - 0.6f * expf(-0.3f * (float)a.layer), osc = 1.f - lam_init;
    const bf16_t* P = a.P;
    for (int pr = wv; pr < 64; pr += 4) { const int tk = pr >> 3, h = pr & 7, row = r0 + tk;
        const float* o1 = a.OC + (size_t)row * 1024 + h * 128, * o2 = a.OC + ((size_t)M_TOT + row) * 1024 + h * 128;
        const float v0 = o1[lane] - lam * o2[lane], v1 = o1[lane + 64] - lam * o2[lane + 64];
        const float ss = wave_sum(v0 * v0 + v1 * v1), r = rsqrtf(ss * (1.f / 128.f) + EPS);
        const float g0 = bf2f(P[(size_t)row * N_IN + C_GA + h * 128 + lane]), g1 = bf2f(P[(size_t)row * N_IN + C_GA + h * 128 + 64 + lane]);
        a.Y[(size_t)row * DM + h * 128 + lane] = f2bf(v0 * r * a.subln_g[lane] * osc * silu_f(g0));
        a.Y[(size_t)row * DM + h * 128 + 64 + lane] = f2bf(v1 * r * a.subln_g[64 + lane] * osc * silu_f(g1)); }
    for (int cc = tid; cc < 512; cc += 256) { const int g = cc >> 7, hw = 1 << g;
        for (int tk = 0; tk < 8; ++tk) { const int tl = tl0 + tk, lo = max(tl - hw, 0), hi = min(tl + hw, L); float s = 0.f;
            for (int p = lo; p < hi; ++p) s += bf2f(P[(size_t)(seq0 + p) * N_IN + C_UP + cc]);
            dsh[tk][cc] = s / (float)(hi - lo) - bf2f(P[(size_t)(seq0 + tl) * N_IN + C_UP + cc]); } }
    __syncthreads();
    for (int n = tid; n < 512; n += 256) { const int g = n >> 7, dl = n & 127; float acc[8];
#pragma unroll
        for (int tk = 0; tk < 8; ++tk) acc[tk] = 0.f;
        const float* wp = a.w_pool + (size_t)g * 128 * 128 + dl;
        for (int c = 0; c < 128; ++c) { const float w = wp[(size_t)c * 128];
#pragma unroll
            for (int tk = 0; tk < 8; ++tk) acc[tk] += dsh[tk][g * 128 + c] * w; }
        const float ps = a.pool_scale[n];
#pragma unroll
        for (int tk = 0; tk < 8; ++tk) { const int row = r0 + tk; const float gp = bf2f(P[(size_t)row * N_IN + C_GP + n]);
            a.Y[(size_t)row * DM + 1024 + n] = f2bf(acc[tk] * ps * silu_f(gp)); } }
    for (int c = tid; c < 512; c += 256) { float y[8];
#pragma unroll
        for (int tk = 0; tk < 8; ++tk) y[tk] = a.b_dw[c];
#pragma unroll
        for (int p = 0; p < 38; ++p) { const int tl = tl0 - 15 + p; float u = 0.f;
            if (tl >= 0 && tl < L) { const bf16_t* rp = P + (size_t)(seq0 + tl) * N_IN; u = bf2f(rp[C_CA + c]) * sigm_f(bf2f(rp[C_CB + c])); }
#pragma unroll
            for (int tk = 0; tk < 8; ++tk) { const int j = p - tk; if (j >= 0 && j < 31) y[tk] += u * a.w_dw[j * 512 + c]; } }
#pragma unroll
        for (int tk = 0; tk < 8; ++tk) ysh[tk][c] = y[tk]; }
    __syncthreads();
    for (int tk = wv; tk < 8; tk += 4) { float v[8], s = 0.f;
#pragma unroll
        for (int j = 0; j < 8; ++j) { v[j] = ysh[tk][lane + 64 * j]; s += v[j]; }
        const float mu = wave_sum(s) * (1.f / 512.f); float q = 0.f;
#pragma unroll
        for (int j = 0; j < 8; ++j) { v[j] -= mu; q += v[j] * v[j]; }
        const float rs = rsqrtf(wave_sum(q) * (1.f / 512.f) + EPS);
#pragma unroll
        for (int j = 0; j < 8; ++j) { const int c = lane + 64 * j; const float z = v[j] * rs * a.ln_g[c] + a.ln_b[c]; ysh[tk][c] = silu_f(z); } }
    __syncthreads();
    for (int n = tid; n < 512; n += 256) { float acc[8];
#pragma unroll
        for (int tk = 0; tk < 8; ++tk) acc[tk] = 0.f;
        for (int c = 0; c < 512; ++c) { const float w = a.w_pw2[(size_t)c * 512 + n];
#pragma unroll
            for (int tk = 0; tk < 8; ++tk) acc[tk] += ysh[tk][c] * w; }
#pragma unroll
        for (int tk = 0; tk < 8; ++tk) { const int row = r0 + tk; const float gc = bf2f(P[(size_t)row * N_IN + C_GC + n]);
            a.Y[(size_t)row * DM + 1536 + n] = f2bf(acc[tk] * silu_f(gc)); } }
}

__global__ void k_final(float* __restrict__ out, const float* __restrict__ g) {
    const int row = blockIdx.x * 4 + (threadIdx.x >> 6), lane = threadIdx.x & 63;
    float4* p = (float4*)(out + (size_t)row * DM); float4 v[8]; float ss = 0.f;
#pragma unroll
    for (int j = 0; j < 8; ++j) { v[j] = p[lane + 64 * j]; ss += v[j].x * v[j].x + v[j].y * v[j].y + v[j].z * v[j].z + v[j].w * v[j].w; }
    const float rstd = rsqrtf(wave_sum(ss) * (1.f / DM) + EPS);
#pragma unroll
    for (int j = 0; j < 8; ++j) { const float4 gg = *(const float4*)(g + (lane + 64 * j) * 4);
        p[lane + 64 * j] = make_float4(v[j].x * rstd * gg.x, v[j].y * rstd * gg.y, v[j].z * rstd * gg.z, v[j].w * rstd * gg.w); }
}

extern "C" void kernel_launch(void* const* d_in, const int* in_sizes, int n_in, void* d_out, int out_size, void* d_ws, size_t ws_size, hipStream_t stream) {
    if (n_in != 22 || ws_size < WS_END) { fprintf(stderr, "kernel_launch: unexpected n_in %d / ws %zu\n", n_in, ws_size); return; }
    const float* x = (const float*)d_in[0]; const float* c = (const float*)d_in[1]; const float* ctx = (const float*)d_in[2]; const float* c_ctx = (const float*)d_in[3];
    const float* w_mod = (const float*)d_in[4]; const float* b_mod = (const float*)d_in[5]; const float* norm_g = (const float*)d_in[6]; const float* w_in = (const float*)d_in[7];
    const float* lq1 = (const float*)d_in[8]; const float* lk1 = (const float*)d_in[9]; const float* lq2 = (const float*)d_in[10]; const float* lk2 = (const float*)d_in[11];
    const float* subln_g = (const float*)d_in[12]; const float* w_pool = (const float*)d_in[13]; const float* pool_scale = (const float*)d_in[14]; const float* w_dw = (const float*)d_in[15];
    const float* b_dw = (const float*)d_in[16]; const float* ln_g = (const float*)d_in[17]; const float* ln_b = (const float*)d_in[18]; const float* w_pw2 = (const float*)d_in[19];
    const float* w_out = (const float*)d_in[20]; const float* final_g = (const float*)d_in[21];
    unsigned char* ws = (unsigned char*)d_ws; float* out = (float*)d_out;
    float* MOD = (float*)(ws + WS_MOD); bf16_t* WIN = (bf16_t*)(ws + WS_WIN); bf16_t* WOUT = (bf16_t*)(ws + WS_WOUT);
    float* CTXRES = (float*)(ws + WS_CTXRES); bf16_t* H = (bf16_t*)(ws + WS_H); bf16_t* P = (bf16_t*)(ws + WS_P); bf16_t* Y = (bf16_t*)(ws + WS_YMIX); float* OC = (float*)(ws + WS_OC);

    hipLaunchKernelGGL(k_transpose, dim3(N_IN / 32, DM / 32, 2), dim3(256), 0, stream, w_in, WIN, DM, N_IN);
    hipLaunchKernelGGL(k_transpose, dim3(DM / 32, DM / 32, 2), dim3(256), 0, stream, w_out, WOUT, DM, DM);
    hipLaunchKernelGGL(k_mod, dim3(N_MOD / 64, 2), dim3(256), 0, stream, c, c_ctx, w_mod, b_mod, lq1, lk1, lq2, lk2, MOD);
    for (int l = 0; l < DEPTH; ++l) {
        const float* MODl = MOD + (size_t)l * 5 * N_MOD;
        const float* xsrc = l == 0 ? x : out; const float* csrc = l == 0 ? ctx : CTXRES;
        hipLaunchKernelGGL(k_norm, dim3(M_TOT / 4), dim3(256), 0, stream, xsrc, csrc, norm_g + l * DM, MODl, H);
        EpiArgs e0{}; e0.P = P;
        hipLaunchKernelGGL(k_gemm_naive<0>, dim3(N_IN / 64, M_TOT / 64), dim3(256), 0, stream, H, WIN + (size_t)l * N_IN * DM, M_TOT, N_IN, DM, e0);
        hipLaunchKernelGGL(k_attn_naive, dim3(SEQ / 64, 16, BATCH), dim3(64), 0, stream, P, OC, 0);
        if (l == 0) hipLaunchKernelGGL(k_attn_naive, dim3(CTX / 64, 16, BATCH), dim3(64), 0, stream, P, OC, 1);
        MixArgs m{}; m.P = P; m.OC = OC; m.Y = Y; m.MOD = MOD; m.subln_g = subln_g + l * 128; m.w_pool = w_pool + (size_t)l * 4 * 128 * 128; m.pool_scale = pool_scale + l * 512;
        m.w_dw = w_dw + (size_t)l * 31 * 512; m.b_dw = b_dw + l * 512; m.ln_g = ln_g + l * 512; m.ln_b = ln_b + l * 512; m.w_pw2 = w_pw2 + (size_t)l * 512 * 512; m.layer = l;
        hipLaunchKernelGGL(k_mix_naive, dim3(M_TOT / 8), dim3(256), 0, stream, m);
        EpiArgs e1{}; e1.MODl = MODl; e1.xin = xsrc; e1.cin = csrc; e1.xout = out; e1.cout = CTXRES; e1.last = (l == DEPTH - 1);
        hipLaunchKernelGGL(k_gemm_naive<1>, dim3(DM / 64, M_TOT / 64), dim3(256), 0, stream, Y, WOUT + (size_t)l * DM * DM, M_TOT, DM, DM, e1);
    }
    hipLaunchKernelGGL(k_final, dim3(BATCH * SEQ / 4), dim3(256), 0, stream, out, final_g);
}
```

```cpp
#include <hip/hip_runtime.h>
#include <hip/hip_cooperative_groups.h>
#include <cstdint>
#include <cstdio>
#include <cmath>
namespace cg = cooperative_groups;

#ifndef MK_USE_CG
#define MK_USE_CG 1
#endif
#ifndef MK_PER_PHASE
#define MK_PER_PHASE 0
#endif

constexpr int DM = 2048, BATCH = 4, SEQ = 2048, DEPTH = 2, CTX = 256;
constexpr int N_IN = 6656, N_MOD = 6144, HEADS = 8;
constexpr int TPB = CTX + SEQ;
constexpr int M_TOT = BATCH * TPB;
constexpr float EPS = 1e-6f;
constexpr int C_Q = 0, C_K = 1024, C_V = 2048, C_GA = 3072, C_UP = 4096, C_GP = 4608, C_CA = 5120, C_CB = 5632, C_GC = 6144;
constexpr int NWAVES = 8, NTHREADS = 512;

#define LAS __attribute__((address_space(3)))
#define GAS __attribute__((address_space(1)))
typedef unsigned short bf16_t;
typedef short bf16x8 __attribute__((ext_vector_type(8)));
typedef short s16x4 __attribute__((ext_vector_type(4)));
typedef float f32x4 __attribute__((ext_vector_type(4)));
typedef float f32x16 __attribute__((ext_vector_type(16)));
typedef unsigned u32x4 __attribute__((ext_vector_type(4)));
typedef unsigned u32x2 __attribute__((ext_vector_type(2)));

__device__ __forceinline__ float bf2f(bf16_t v) { return __uint_as_float(((unsigned)v) << 16); }
__device__ __forceinline__ unsigned f2bf(float f) { unsigned u = __float_as_uint(f); return (u + 0x7fffu + ((u >> 16) & 1u)) >> 16; }
__device__ __forceinline__ unsigned pk2(float lo, float hi) { return f2bf(lo) | (f2bf(hi) << 16); }
__device__ __forceinline__ unsigned cvt_pk_bf16(float lo, float hi) { unsigned r; asm volatile("v_cvt_pk_bf16_f32 %0, %1, %2" : "=v"(r) : "v"(lo), "v"(hi)); return r; }
__device__ __forceinline__ float silu_f(float v) { return v * __builtin_amdgcn_rcpf(1.f + __expf(-v)); }
__device__ __forceinline__ float sigm_f(float v) { return __builtin_amdgcn_rcpf(1.f + __expf(-v)); }
__device__ __forceinline__ float wave_sum(float v) {
#pragma unroll
    for (int o = 1; o < 64; o <<= 1) v += __shfl_xor(v, o);
    return v;
}

__device__ __forceinline__ int opaque_tid() { int t = threadIdx.x; asm volatile("" : "+v"(t)); return t; }

constexpr size_t MiB = 1u << 20;
constexpr size_t WS_CTL = 0, CTL_ZERO_BYTES = 64 * 1024;
constexpr size_t WS_ROPE = 512 * 1024;
constexpr size_t WS_MOD = 1 * MiB;
constexpr size_t WS_WIN = 2 * MiB;
constexpr size_t WS_WOUT = 54 * MiB;
constexpr size_t WS_WPW2 = 70 * MiB;
constexpr size_t WS_WPOOL = 71 * MiB;
constexpr size_t WS_CTXRES = 72 * MiB;
constexpr size_t WS_H = 80 * MiB;
constexpr size_t WS_P = 116 * MiB;
constexpr size_t WS_YMIX = 234 * MiB;
constexpr size_t WS_END = 270 * MiB;
constexpr int CW_BAR = 1024;

constexpr int RING_BYTES = 131072;
constexpr int LDSCTL_OFF = RING_BYTES, MISC_OFF = LDSCTL_OFF + 320;
constexpr int LDS_BYTES = 147456;

namespace pg8 {
constexpr int BM = 256, BK = 64, HALF = 128, HTB = HALF * BK * 2, STAGE_BYTES = 8 * HTB, NXCD = 8, WGM = 8;
__host__ __device__ __forceinline__ int lds_byte(int r, int c) { const int st = (r >> 4) * 2 + (c >> 5), rr = r & 15, cc = c & 31, ob = rr * 64 + cc * 2; return st * 1024 + (ob ^ (((ob >> 9) & 1) << 5)); }
__host__ __device__ __forceinline__ void stage_rc(int b, int& R, int& C) { const int st = b / 1024, sb = b % 1024, swz = sb ^ (((sb >> 9) & 1) << 5); R = (st >> 1) * 16 + swz / 64; C = (st & 1) * 32 + (swz % 64) / 2; }
__host__ __device__ __forceinline__ int perm32(int rho) { const int n = rho >> 4, i = rho & 15; return 8 * (i >> 2) + 4 * n + (i & 3); }

struct Unit { int pm, pn; };
struct Gemm { const bf16_t* A; const bf16_t* Bt; int M, N, K; };

struct TileSched {
    int nM, nN, nreg, nwg, G, c, lat_only;
    __device__ void init(int nM_, int nN_, int nextra, int lat_only_, int G_, int c_) { nM = nM_; nN = nN_; nreg = nM_ * nN_; nwg = nreg + nextra; lat_only = lat_only_; G = G_; c = c_; }
    __device__ bool next(int i, Unit& u) const {
        const long L = (long)i * G + c; if (L >= nwg) return false;
        int wgid = (int)L; { const int q = nwg / NXCD, r = nwg % NXCD, xcd = wgid % NXCD, off = wgid / NXCD; wgid = (xcd < r ? xcd * (q + 1) : r * (q + 1) + (xcd - r) * q) + off; }
        if (wgid < nreg) {
            const int nig = WGM * nN, gid = wgid / nig, fm = gid * WGM, gsz = (nM - fm) < WGM ? (nM - fm) : WGM;
            const int j = fm + ((wgid % nig) % gsz); u.pn = (wgid % nig) / gsz;
            u.pm = lat_only ? (j >> 3) * 9 + 1 + (j & 7) : j;
        } else { const int e = wgid - nreg; u.pm = (e >> 3) * 9; u.pn = 4 + (e & 7); }
        return true;
    }
    __device__ __forceinline__ void a_ready(const Unit&) const {}
    __device__ __forceinline__ void done(const Unit&) const {}
};

struct EpiIn {
    static constexpr bool PERM = false, AFTER_DRAIN = false;
    bf16_t* P; const float* rope;
    __device__ __forceinline__ void operator()(const f32x4 (&acc)[2][2][4][2], const Unit& u, int wr, int wc, int fr, int fq) const {
        const int bt = u.pm % 9; const bool do_rope = (u.pn < 8) && (bt != 0);
        const int col0 = u.pn * BM + wc * 32 + 4 * fq;
#pragma unroll
        for (int ai = 0; ai < 2; ++ai)
#pragma unroll
            for (int m = 0; m < 4; ++m) {
                const int rl = ai * HALF + wr * 64 + m * 16 + fr; const size_t row = (size_t)u.pm * BM + rl;
                f32x4 cs = {1.f, 1.f, 1.f, 1.f}, sn = {0.f, 0.f, 0.f, 0.f};
                if (do_rope) { const int tl = (bt - 1) * 256 + rl, pos = (wc & 1) ? (tl & 63) : (tl >> 6);
                    const f32x4 a = *(const f32x4*)(rope + (pos * 16 + 4 * fq) * 2), b = *(const f32x4*)(rope + (pos * 16 + 4 * fq) * 2 + 4);
                    cs = (f32x4){a[0], a[2], b[0], b[2]}; sn = (f32x4){a[1], a[3], b[1], b[3]}; }
                bf16_t* rowp = P + row * N_IN + col0;
#pragma unroll
                for (int bj = 0; bj < 2; ++bj) { const f32x4 v0 = acc[ai][bj][m][0], v1 = acc[ai][bj][m][1];
                    const f32x4 o0 = v0 * cs - v1 * sn, o1 = v1 * cs + v0 * sn;
                    u32x2 w0, w1; w0.x = cvt_pk_bf16(o0[0], o0[1]); w0.y = cvt_pk_bf16(o0[2], o0[3]); w1.x = cvt_pk_bf16(o1[0], o1[1]); w1.y = cvt_pk_bf16(o1[2], o1[3]);
                    *(u32x2*)(rowp + bj * HALF) = w0; *(u32x2*)(rowp + bj * HALF + 16) = w1; }
            }
    }
};
struct EpiOut {
    static constexpr bool PERM = false, AFTER_DRAIN = false;
    const float* xin; const float* cin; float* xout; float* cout; const float* MODl;
    __device__ __forceinline__ void operator()(const f32x4 (&acc)[2][2][4][2], const Unit& u, int wr, int wc, int fr, int fq) const {
        const int bt = u.pm % 9, b = u.pm / 9; const bool lat = bt != 0;
        const int col0 = u.pn * BM + wc * 32 + 4 * fq;
        const float* gp = MODl + (size_t)(lat ? b : 4) * N_MOD + 4096 + col0;
        f32x4 gv[2][2];
#pragma unroll
        for (int bj = 0; bj < 2; ++bj)
#pragma unroll
            for (int n = 0; n < 2; ++n) gv[bj][n] = *(const f32x4*)(gp + bj * HALF + n * 16);
        const float* src = lat ? xin : cin; float* dst = lat ? xout : cout;
#pragma unroll
        for (int ai = 0; ai < 2; ++ai)
#pragma unroll
            for (int m = 0; m < 4; ++m) {
                const int rl = ai * HALF + wr * 64 + m * 16 + fr;
                const size_t off = (lat ? ((size_t)b * SEQ + (bt - 1) * 256 + rl) : ((size_t)b * CTX + rl)) * DM + col0;
#pragma unroll
                for (int bj = 0; bj < 2; ++bj)
#pragma unroll
                    for (int n = 0; n < 2; ++n) { const f32x4 old = *(const f32x4*)(src + off + bj * HALF + n * 16); *(f32x4*)(dst + off + bj * HALF + n * 16) = old + gv[bj][n] * acc[ai][bj][m][n]; }
            }
    }
};

template <class Epi, class Sched, bool ALIGN_EPI = false, bool SP2 = false>
__device__ __forceinline__ void gemm_phase(LAS unsigned char* lds, const Gemm g, const Sched& S, const Epi& E) {
    const int tid = opaque_tid(), wid = __builtin_amdgcn_readfirstlane(tid >> 6), lane = tid & 63, wr = wid >> 2, wc = wid & 3, fr = lane & 15, fq = lane >> 4;
    const int K = g.K, nt = K / BK;
    unsigned voffA[2], voffB[2];
#pragma unroll
    for (int i = 0; i < 2; ++i) { int R, C; stage_rc(tid * 16 + i * 8192, R, C); const int Rb = Epi::PERM ? ((R & ~31) + perm32(R & 31)) : R;
        voffA[i] = (unsigned)(R * K + C) * 2u; voffB[i] = (unsigned)(Rb * K + C) * 2u; }
    const size_t kstep = (size_t)(BK * 2);
    const size_t hstep = (size_t)HALF * K * 2;
    const size_t tstep = 2 * hstep;
    const unsigned ldsw = (unsigned)wid * 1024u;
    const int aoff = lds_byte(wr * 64 + fr, fq * 8), boff = lds_byte(wc * 32 + fr, fq * 8);
#define PG8_SA(b, h) (((b) * 2 + (h)) * HTB)
#define PG8_SB(b, h) ((4 + (b) * 2 + (h)) * HTB)
#define PG8_STAGE(bufoff, gbase, voff) do { _Pragma("unroll") for (int _i = 0; _i < 2; ++_i) \
        __builtin_amdgcn_global_load_lds((const unsigned*)((const char*)(gbase) + (voff)[_i]), (LAS unsigned*)(lds + (bufoff) + ldsw + _i * 8192), 16, 0, 0); } while (0)
#define PG8_LDA(dst, b, h) do { _Pragma("unroll") for (int m = 0; m < 4; ++m) _Pragma("unroll") for (int k = 0; k < 2; ++k) dst[m][k] = *(const LAS bf16x8*)(lds + PG8_SA(b, h) + aoff + m * 2048 + k * 1024); } while (0)
#define PG8_LDB(dst, b, h) do { _Pragma("unroll") for (int n = 0; n < 2; ++n) _Pragma("unroll") for (int k = 0; k < 2; ++k) dst[n][k] = *(const LAS bf16x8*)(lds + PG8_SB(b, h) + boff + n * 2048 + k * 1024); } while (0)
#define PG8_MMA(ai, bj, At, Bt) do { __builtin_amdgcn_s_setprio(1); _Pragma("unroll") for (int m = 0; m < 4; ++m) _Pragma("unroll") for (int n = 0; n < 2; ++n) _Pragma("unroll") for (int k = 0; k < 2; ++k) \
        acc[ai][bj][m][n] = __builtin_amdgcn_mfma_f32_16x16x32_bf16(Bt[n][k], At[m][k], acc[ai][bj][m][n], 0, 0, 0); __builtin_amdgcn_s_setprio(0); } while (0)
#define PG8_WAIT_V(n) asm volatile("s_waitcnt vmcnt(" #n ")" ::: "memory")
#define PG8_WAIT_L(n) asm volatile("s_waitcnt lgkmcnt(" #n ")" ::: "memory")
#define PG8_BAR __builtin_amdgcn_s_barrier()
#define PG8_SCHED __builtin_amdgcn_sched_barrier(0)
    Unit cur, nxt; int ui = 0;
    if (!S.next(0, cur)) return;
    f32x4 acc[2][2][4][2];
#pragma unroll
    for (int a = 0; a < 2; ++a)
#pragma unroll
        for (int b = 0; b < 2; ++b)
#pragma unroll
            for (int m = 0; m < 4; ++m)
#pragma unroll
                for (int n = 0; n < 2; ++n) acc[a][b][m][n] = (f32x4){0.f, 0.f, 0.f, 0.f};
    bf16x8 At[4][2], B0[2][2], B1[2][2];
    const char* cA = (const char*)g.A + (size_t)cur.pm * tstep; const char* cB = (const char*)g.Bt + (size_t)cur.pn * tstep;
    S.a_ready(cur);
    if constexpr (SP2) {
        PG8_STAGE(PG8_SB(0, 0), cB, voffB); PG8_STAGE(PG8_SB(0, 1), cB + hstep, voffB); PG8_STAGE(PG8_SA(0, 0), cA, voffA); PG8_STAGE(PG8_SA(0, 1), cA + hstep, voffA);
        if (wr == 1) PG8_BAR;
        PG8_WAIT_V(2); PG8_BAR;
        PG8_STAGE(PG8_SB(1, 0), cB + kstep, voffB); PG8_STAGE(PG8_SA(1, 0), cA + kstep, voffA); PG8_STAGE(PG8_SB(1, 1), cB + hstep + kstep, voffB);
        PG8_WAIT_V(6); PG8_BAR;
    } else {
        PG8_STAGE(PG8_SB(0, 0), cB, voffB); PG8_STAGE(PG8_SA(0, 0), cA, voffA); PG8_STAGE(PG8_SB(0, 1), cB + hstep, voffB); PG8_STAGE(PG8_SA(0, 1), cA + hstep, voffA);
        if (wr == 1) PG8_BAR;
        PG8_WAIT_V(4); PG8_BAR;
        PG8_STAGE(PG8_SB(1, 0), cB + kstep, voffB); PG8_STAGE(PG8_SA(1, 0), cA + kstep, voffA); PG8_STAGE(PG8_SB(1, 1), cB + hstep + kstep, voffB);
        PG8_WAIT_V(6); PG8_BAR;
    }
    for (;;) {
        const bool has_next = S.next(ui + 1, nxt);
        const char* nA = has_next ? (const char*)g.A + (size_t)nxt.pm * tstep : cA; const char* nB = has_next ? (const char*)g.Bt + (size_t)nxt.pn * tstep : cB;
        for (int t = 0; t < nt; t += 2) {
            const bool last = (t == nt - 2);
            const char* a1 = cA + (size_t)(t + 1) * kstep;
            const char* a2 = last ? nA : cA + (size_t)(t + 2) * kstep; const char* b2 = last ? nB : cB + (size_t)(t + 2) * kstep;
            const char* a3 = a2 + kstep; const char* b3 = b2 + kstep;
            if (last && has_next) S.a_ready(nxt);
            if constexpr (SP2) {
            PG8_LDB(B0, 0, 0); PG8_LDB(B1, 0, 1); PG8_SCHED; PG8_LDA(At, 0, 0); PG8_STAGE(PG8_SA(1, 1), a1 + hstep, voffA);
            PG8_WAIT_V(8); PG8_WAIT_L(0); PG8_BAR; PG8_MMA(0, 0, At, B0); PG8_MMA(0, 1, At, B1); PG8_BAR; PG8_SCHED;
            PG8_LDA(At, 0, 1); PG8_STAGE(PG8_SB(0, 0), b2, voffB); PG8_STAGE(PG8_SB(0, 1), b2 + hstep, voffB); PG8_STAGE(PG8_SA(0, 0), a2, voffA);
            PG8_WAIT_V(8); PG8_WAIT_L(0); PG8_BAR; PG8_MMA(1, 0, At, B0); PG8_MMA(1, 1, At, B1); PG8_BAR; PG8_SCHED;
            PG8_LDB(B0, 1, 0); PG8_LDB(B1, 1, 1); PG8_SCHED; PG8_LDA(At, 1, 0); PG8_STAGE(PG8_SA(0, 1), a2 + hstep, voffA);
            PG8_WAIT_V(8); PG8_WAIT_L(0); PG8_BAR; PG8_MMA(0, 0, At, B0); PG8_MMA(0, 1, At, B1); PG8_BAR; PG8_SCHED;
            PG8_LDA(At, 1, 1); PG8_STAGE(PG8_SB(1, 0), b3, voffB); PG8_STAGE(PG8_SB(1, 1), b3 + hstep, voffB); PG8_STAGE(PG8_SA(1, 0), a3, voffA);
            PG8_WAIT_V(8); PG8_WAIT_L(0); PG8_BAR; PG8_MMA(1, 0, At, B0); PG8_MMA(1, 1, At, B1); PG8_BAR; PG8_SCHED;
            } else {
            PG8_LDB(B0, 0, 0); PG8_SCHED; PG8_LDA(At, 0, 0); PG8_STAGE(PG8_SA(1, 1), a1 + hstep, voffA);
            PG8_WAIT_L(8); PG8_BAR; PG8_WAIT_L(0); PG8_MMA(0, 0, At, B0); PG8_BAR; PG8_SCHED;
            PG8_LDB(B1, 0, 1); PG8_STAGE(PG8_SB(0, 0), b2, voffB);
            PG8_BAR; PG8_WAIT_L(0); PG8_MMA(0, 1, At, B1); PG8_BAR;
            PG8_LDA(At, 0, 1); PG8_STAGE(PG8_SA(0, 0), a2, voffA);
            PG8_BAR; PG8_WAIT_L(0); PG8_MMA(1, 0, At, B0); PG8_BAR; PG8_SCHED;
            PG8_STAGE(PG8_SB(0, 1), b2 + hstep, voffB);
            PG8_WAIT_V(6); PG8_BAR; PG8_MMA(1, 1, At, B1); PG8_BAR;
            PG8_LDB(B0, 1, 0); PG8_SCHED; PG8_LDA(At, 1, 0); PG8_STAGE(PG8_SA(0, 1), a2 + hstep, voffA);
            PG8_WAIT_L(8); PG8_BAR; PG8_WAIT_L(0); PG8_MMA(0, 0, At, B0); PG8_BAR; PG8_SCHED;
            PG8_LDB(B1, 1, 1); PG8_STAGE(PG8_SB(1, 0), b3, voffB);
            PG8_BAR; PG8_WAIT_L(0); PG8_MMA(0, 1, At, B1); PG8_BAR;
            PG8_LDA(At, 1, 1); PG8_STAGE(PG8_SA(1, 0), a3, voffA);
            PG8_BAR; PG8_WAIT_L(0); PG8_MMA(1, 0, At, B0); PG8_BAR; PG8_SCHED;
            PG8_STAGE(PG8_SB(1, 1), b3 + hstep, voffB);
            PG8_WAIT_V(6); PG8_BAR; PG8_MMA(1, 1, At, B1); PG8_BAR;
            }
        }
        if constexpr (ALIGN_EPI) { if (wr == 0) PG8_BAR; }
        if constexpr (!Epi::AFTER_DRAIN) { E(acc, cur, wr, wc, fr, fq); S.done(cur); }
        if (!has_next) break;
#pragma unroll
        for (int a = 0; a < 2; ++a)
#pragma unroll
            for (int b = 0; b < 2; ++b)
#pragma unroll
                for (int m = 0; m < 4; ++m)
#pragma unroll
                    for (int n = 0; n < 2; ++n) acc[a][b][m][n] = (f32x4){0.f, 0.f, 0.f, 0.f};
        cur = nxt; cA = nA; cB = nB; ++ui;
        if constexpr (ALIGN_EPI) { if (wr == 1) PG8_BAR; }
    }
    PG8_WAIT_V(0);
    if constexpr (!ALIGN_EPI) { if (wr == 0) PG8_BAR; }
    PG8_BAR;
#undef PG8_SA
#undef PG8_SB
#undef PG8_STAGE
#undef PG8_LDA
#undef PG8_LDB
#undef PG8_MMA
#undef PG8_WAIT_V
#undef PG8_WAIT_L
#undef PG8_BAR
#undef PG8_SCHED
}
}

namespace att {
constexpr int KVBLK = 64;
constexpr int SHM_V = KVBLK * 128 * 2, SHM_K = KVBLK * 128 * 2;
constexpr int OFF_V = 0, OFF_K = 2 * SHM_V, OFF_WS = 2 * SHM_V + 2 * SHM_K, ATT_LDS = OFF_WS + NWAVES * 64 * 4;
constexpr float SCALE = 0.125f, THR = 8.f;
#define KSWZ(row, colB) ((row) * 256 + ((colB) ^ (((row) & 7) << 4)))
#define SBAR() __builtin_amdgcn_sched_barrier(0)
__device__ __forceinline__ int crow(int r, int hi) { return (r & 3) + 8 * (r >> 2) + 4 * hi; }
__device__ __forceinline__ void partialSM(f32x16& p0, f32x16& p1, float& m_reg, float& mn, float& alpha) {
    constexpr float C = SCALE * 1.4426950408889634f;
    float pmax = p0[0];
#pragma unroll
    for (int r = 1; r < 16; ++r) pmax = fmaxf(pmax, p0[r]);
#pragma unroll
    for (int r = 0; r < 16; ++r) pmax = fmaxf(pmax, p1[r]);
    { auto rr = __builtin_amdgcn_permlane32_swap(__float_as_uint(pmax), __float_as_uint(pmax), false, false);
      pmax = fmaxf(__uint_as_float(rr[0]), __uint_as_float(rr[1])); }
    if (__builtin_expect(__all(pmax - m_reg <= THR / SCALE), 1)) { mn = m_reg; alpha = 1.f; }
    else { mn = fmaxf(m_reg, pmax); alpha = __builtin_amdgcn_exp2f((m_reg - mn) * C); m_reg = mn; }
    const float mnC = -mn * C;
#pragma unroll
    for (int r = 0; r < 16; ++r) p0[r] = fmaf(p0[r], C, mnC);
#pragma unroll
    for (int r = 0; r < 16; ++r) p1[r] = fmaf(p1[r], C, mnC);
#pragma unroll
    for (int r = 0; r < 16; ++r) p0[r] = __builtin_amdgcn_exp2f(p0[r]);
}
__device__ __forceinline__ void finishSM(f32x16& p0, f32x16& p1, float alpha, float& l_reg, bf16x8& pa0, bf16x8& pa1, bf16x8& pa2, bf16x8& pa3) {
#pragma unroll
    for (int r = 0; r < 16; ++r) p1[r] = __builtin_amdgcn_exp2f(p1[r]);
    float ps = 0;
#pragma unroll
    for (int r = 0; r < 16; ++r) ps += p0[r];
#pragma unroll
    for (int r = 0; r < 16; ++r) ps += p1[r];
    { auto rr = __builtin_amdgcn_permlane32_swap(__float_as_uint(ps), __float_as_uint(ps), false, false);
      ps = __uint_as_float(rr[0]) + __uint_as_float(rr[1]); }
    l_reg = l_reg * alpha + ps;
#define PK4(P, BASE, OUT) do { unsigned a0 = cvt_pk_bf16(P[BASE + 0], P[BASE + 1]), a1 = cvt_pk_bf16(P[BASE + 2], P[BASE + 3]);   \
    unsigned b0 = cvt_pk_bf16(P[BASE + 4], P[BASE + 5]), b1 = cvt_pk_bf16(P[BASE + 6], P[BASE + 7]);                              \
    auto r0 = __builtin_amdgcn_permlane32_swap(a0, b0, false, false); auto r1 = __builtin_amdgcn_permlane32_swap(a1, b1, false, false); \
    u32x4 w = {r0[0], r1[0], r0[1], r1[1]}; OUT = *reinterpret_cast<bf16x8*>(&w); } while (0)
    PK4(p0, 0, pa0); PK4(p0, 8, pa1); PK4(p1, 0, pa2); PK4(p1, 8, pa3);
#undef PK4
}
__device__ __forceinline__ void qkt(f32x16& p0, f32x16& p1, const char* Ks, const bf16x8* qr, int r32, int hi, int cbase) {
    p0 = f32x16{}; p1 = f32x16{};
#pragma unroll
    for (int d0 = 0; d0 < 4; ++d0) { const int cb = cbase + (d0 * 16 + hi * 8) * 2;
        const bf16x8 b0 = *reinterpret_cast<const bf16x8*>(Ks + KSWZ(r32, cb));
        const bf16x8 b1 = *reinterpret_cast<const bf16x8*>(Ks + KSWZ(32 + r32, cb));
        p0 = __builtin_amdgcn_mfma_f32_32x32x16_bf16(b0, qr[d0], p0, 0, 0, 0);
        p1 = __builtin_amdgcn_mfma_f32_32x32x16_bf16(b1, qr[d0], p1, 0, 0, 0); }
}
__device__ __forceinline__ int v_st(int k, int c) { const int kk = (k & ~0xC) | ((k & 4) << 1) | ((k & 8) >> 1); return ((kk >> 3) * 4 + (c >> 5)) * 512 + ((kk & 7) * 32 + (c & 31)) * 2; }
__device__ __forceinline__ int v_rd_base(int lane) { return ((lane & 3) << 3) | (((lane >> 2) & 3) << 6) | (((lane >> 4) & 1) << 5) | (((lane >> 5) & 1) << 8); }
constexpr int v_rd_off(int d0, int ks, int half) { return d0 * 512 + ks * 4096 + half * 2048; }
template <int OFF> __device__ __forceinline__ s16x4 tr_read(int vb) {
    s16x4 r; asm volatile("ds_read_b64_tr_b16 %0, %1 offset:%2" : "=&v"(r) : "v"(vb), "i"(OFF) : "memory"); return r;
}
template <int D0> __device__ __forceinline__ void pv_one(f32x16& od, int vb, bf16x8 pa0, bf16x8 pa1, bf16x8 pa2, bf16x8 pa3) {
    const s16x4 l0 = tr_read<v_rd_off(D0, 0, 0)>(vb), h0 = tr_read<v_rd_off(D0, 0, 1)>(vb), l1 = tr_read<v_rd_off(D0, 1, 0)>(vb), h1 = tr_read<v_rd_off(D0, 1, 1)>(vb);
    const s16x4 l2 = tr_read<v_rd_off(D0, 2, 0)>(vb), h2 = tr_read<v_rd_off(D0, 2, 1)>(vb), l3 = tr_read<v_rd_off(D0, 3, 0)>(vb), h3 = tr_read<v_rd_off(D0, 3, 1)>(vb);
    asm volatile("s_waitcnt lgkmcnt(0)" ::: "memory"); SBAR();
#define PK(L, H) (bf16x8){L[0], L[1], L[2], L[3], H[0], H[1], H[2], H[3]}
    od = __builtin_amdgcn_mfma_f32_32x32x16_bf16(pa0, PK(l0, h0), od, 0, 0, 0);
    od = __builtin_amdgcn_mfma_f32_32x32x16_bf16(pa1, PK(l1, h1), od, 0, 0, 0);
    od = __builtin_amdgcn_mfma_f32_32x32x16_bf16(pa2, PK(l2, h2), od, 0, 0, 0);
    od = __builtin_amdgcn_mfma_f32_32x32x16_bf16(pa3, PK(l3, h3), od, 0, 0, 0);
#undef PK
}
__device__ __forceinline__ void pv_d0(f32x16* o, int vb, bf16x8 pa0, bf16x8 pa1, bf16x8 pa2, bf16x8 pa3) {
    pv_one<0>(o[0], vb, pa0, pa1, pa2, pa3); pv_one<1>(o[1], vb, pa0, pa1, pa2, pa3); pv_one<2>(o[2], vb, pa0, pa1, pa2, pa3); pv_one<3>(o[3], vb, pa0, pa1, pa2, pa3);
}

__device__ __forceinline__ void attn_unit(const bf16_t* __restrict__ P, bf16_t* __restrict__ Y, int qrow0, int krow0, int nkeys, int h, float lam, float osc, const float* __restrict__ subln_g, char* lds) {
    const int tid = opaque_tid(), wid = tid >> 6, lane = tid & 63, r32 = lane & 31, hi = lane >> 5, rg = wid & 3, comp = wid >> 2;
    char* V_lds = lds + OFF_V; char* K_lds = lds + OFF_K;
    float* ws = (float*)(lds + OFF_WS) + wid * 64; float* li_l = ws; float* al_l = ws + 32;
    float m_reg = -1e30f, l_reg = 0; f32x16 o[4] = {}; bf16x8 qr[4];
    const bf16_t* Qw = P + (size_t)(qrow0 + rg * 32 + r32) * N_IN + C_Q + h * 128 + comp * 64 + hi * 8;
#pragma unroll
    for (int d0 = 0; d0 < 4; ++d0) qr[d0] = *reinterpret_cast<const bf16x8*>(Qw + d0 * 16);
    const bf16_t* Kh = P + (size_t)krow0 * N_IN + C_K + h * 128; const bf16_t* Vh = P + (size_t)krow0 * N_IN + C_V + h * 128;
    const int sr = tid >> 4, sc = (tid & 15) * 8, vst0 = v_st(sr, sc), vst1 = v_st(32 + sr, sc);
    const int vb0 = (int)(uintptr_t)V_lds + v_rd_base(lane);
    const int cbase = comp * 128;
    struct { bf16x8 vs0, vs1, ks0, ks1; } sr_[2];
#define SLOAD(i, k0) do { sr_[i].vs0 = *reinterpret_cast<const bf16x8*>(&Vh[(size_t)((k0) + sr) * N_IN + sc]); sr_[i].vs1 = *reinterpret_cast<const bf16x8*>(&Vh[(size_t)((k0) + 32 + sr) * N_IN + sc]); \
    sr_[i].ks0 = *reinterpret_cast<const bf16x8*>(&Kh[(size_t)((k0) + sr) * N_IN + sc]); sr_[i].ks1 = *reinterpret_cast<const bf16x8*>(&Kh[(size_t)((k0) + 32 + sr) * N_IN + sc]); } while (0)
#define SWRITE(b, i) do { *(bf16x8*)(V_lds + (b) * SHM_V + vst0) = sr_[i].vs0; *(bf16x8*)(V_lds + (b) * SHM_V + vst1) = sr_[i].vs1; const int kc = sc * 2; \
    *(bf16x8*)(K_lds + (b) * SHM_K + KSWZ(sr, kc)) = sr_[i].ks0; *(bf16x8*)(K_lds + (b) * SHM_K + KSWZ(32 + sr, kc)) = sr_[i].ks1; } while (0)
#define SWAIT() asm volatile("s_waitcnt vmcnt(4)" ::: "memory")
#define RESC(a) do { if (__any((a) < 1.f)) { if (hi == 0) al_l[r32] = (a); asm volatile("s_waitcnt lgkmcnt(0)" ::: "memory"); \
    _Pragma("unroll") for (int d = 0; d < 4; ++d) _Pragma("unroll") for (int r = 0; r < 16; ++r) o[d][r] *= al_l[crow(r, hi)]; } } while (0)
    f32x16 pA0, pA1, pB0, pB1; float mnA, mnB, alA, alB; bf16x8 pa0, pa1, pa2, pa3; const int NT = nkeys / KVBLK;
    constexpr int SE = 0, SO = 1;
    SLOAD(SE, 0); asm volatile("s_waitcnt vmcnt(0)" ::: "memory"); SWRITE(0, SE); __syncthreads();
    qkt(pA0, pA1, K_lds, qr, r32, hi, cbase); partialSM(pA0, pA1, m_reg, mnA, alA);
    SLOAD(SO, KVBLK); if (2 < NT) SLOAD(SE, 2 * KVBLK);
    SWAIT(); SWRITE(1, SO); __syncthreads();
    for (int j = 1; j + 1 < NT; j += 2) {
        SBAR(); qkt(pB0, pB1, K_lds + SHM_K, qr, r32, hi, cbase);
        finishSM(pA0, pA1, alA, l_reg, pa0, pa1, pa2, pa3); SBAR();
        SLOAD(SO, (j + 2) * KVBLK); SBAR();
        pv_d0(o, vb0, pa0, pa1, pa2, pa3); partialSM(pB0, pB1, m_reg, mnB, alB);
        __syncthreads(); SWAIT(); SWRITE(0, SE);
        RESC(alB); __syncthreads();
        SBAR(); qkt(pA0, pA1, K_lds, qr, r32, hi, cbase);
        finishSM(pB0, pB1, alB, l_reg, pa0, pa1, pa2, pa3); SBAR();
        if (j + 3 < NT) SLOAD(SE, (j + 3) * KVBLK); SBAR();
        pv_d0(o, vb0 + SHM_V, pa0, pa1, pa2, pa3); partialSM(pA0, pA1, m_reg, mnA, alA);
        __syncthreads(); SWAIT(); SWRITE(1, SO);
        RESC(alA); __syncthreads();
    }
    SBAR(); qkt(pB0, pB1, K_lds + SHM_K, qr, r32, hi, cbase);
    finishSM(pA0, pA1, alA, l_reg, pa0, pa1, pa2, pa3); SBAR();
    pv_d0(o, vb0, pa0, pa1, pa2, pa3); partialSM(pB0, pB1, m_reg, mnB, alB);
    __syncthreads(); RESC(alB);
    finishSM(pB0, pB1, alB, l_reg, pa0, pa1, pa2, pa3); SBAR();
    pv_d0(o, vb0 + SHM_V, pa0, pa1, pa2, pa3);
    if (hi == 0) li_l[r32] = l_reg; asm volatile("s_waitcnt lgkmcnt(0)" ::: "memory");
#pragma unroll
    for (int r = 0; r < 16; ++r) { const float rl = __builtin_amdgcn_rcpf(li_l[crow(r, hi)]);
#pragma unroll
        for (int d0 = 0; d0 < 4; ++d0) o[d0][r] *= rl; }
    __syncthreads();
    float* X = (float*)lds + (size_t)rg * 64 * 64 + lane;
    if (comp == 1) {
#pragma unroll
        for (int d0 = 0; d0 < 4; ++d0)
#pragma unroll
            for (int r = 0; r < 16; ++r) X[(d0 * 16 + r) * 64] = o[d0][r];
    }
    __syncthreads();
    if (comp == 0) {
        float rs[16];
#pragma unroll
        for (int r = 0; r < 16; ++r) { float ss = 0.f;
#pragma unroll
            for (int d0 = 0; d0 < 4; ++d0) { o[d0][r] -= lam * X[(d0 * 16 + r) * 64]; ss += o[d0][r] * o[d0][r]; }
#pragma unroll
            for (int x = 1; x < 32; x <<= 1) ss += __shfl_xor(ss, x);
            rs[r] = rsqrtf(ss * (1.f / 128.f) + EPS) * osc; }
#pragma unroll
        for (int d0 = 0; d0 < 4; ++d0) { const int col = d0 * 32 + r32; const float sg = subln_g[col];
#pragma unroll
            for (int r = 0; r < 16; ++r) { const size_t row = (size_t)(qrow0 + rg * 32 + crow(r, hi));
                const float g = bf2f(P[row * N_IN + C_GA + h * 128 + col]);
                Y[row * DM + h * 128 + col] = (bf16_t)f2bf(o[d0][r] * rs[r] * sg * silu_f(g)); } }
    }
    __syncthreads();
#undef SLOAD
#undef SWRITE
#undef SWAIT
#undef RESC
}
#undef KSWZ
#undef SBAR
}

namespace mixu {
constexpr int TT = 32;
constexpr int OFF_YS = 0;
constexpr int AB_STRIDE = 1040;
constexpr int OFF_AB = 65536;
struct Args { const bf16_t* P; bf16_t* Y; const bf16_t* wpool_t; const float* pool_scale; const float* w_dw; const float* b_dw; const float* ln_g; const float* ln_b; const bf16_t* wpw2_t; };

template <int HW> __device__ __forceinline__ void pool_diff(const bf16_t* __restrict__ up, int tl0, int L, LAS unsigned char* ab, int c) {
    float u[TT + 2 * HW];
#pragma unroll
    for (int p = 0; p < TT + 2 * HW; ++p) { const int tl = tl0 - HW + p; u[p] = (tl >= 0 && tl < L) ? bf2f(up[(size_t)tl * N_IN]) : 0.f; }
    float s = 0.f;
#pragma unroll
    for (int p = 0; p < 2 * HW; ++p) s += u[p];
#pragma unroll
    for (int tk = 0; tk < TT; ++tk) { const int tl = tl0 + tk; const int lo = max(tl - HW, 0), hi = min(tl + HW, L);
        const float d = s / (float)(hi - lo) - u[tk + HW];
        *(LAS bf16_t*)(ab + tk * AB_STRIDE + c * 2) = (bf16_t)f2bf(d);
        if (tk + 1 < TT) s += u[tk + 2 * HW] - u[tk]; }
}

__device__ __forceinline__ void mix_unit(const Args& a, int row0, LAS unsigned char* lds) {
    const int tid = opaque_tid(), wid = __builtin_amdgcn_readfirstlane(tid >> 6), lane = tid & 63, fr = lane & 15, fq = lane >> 4;
    const int b = row0 / TPB, t0 = row0 % TPB; const bool isctx = t0 < CTX;
    const int seq0 = b * TPB + (isctx ? 0 : CTX), L = isctx ? CTX : SEQ, tl0 = isctx ? t0 : t0 - CTX;
    LAS unsigned char* ab = lds + OFF_AB; LAS float* ys = (LAS float*)(lds + OFF_YS);
    const bf16_t* P = a.P;
    { const int c = tid; const bf16_t* up = P + (size_t)seq0 * N_IN + C_UP + c;
      switch (wid >> 1) { case 0: pool_diff<1>(up, tl0, L, ab, c); break; case 1: pool_diff<2>(up, tl0, L, ab, c); break; case 2: pool_diff<4>(up, tl0, L, ab, c); break; default: pool_diff<8>(up, tl0, L, ab, c); break; } }
    __syncthreads();
    {
      const int g = wid >> 1, nh = wid & 1;
      f32x4 acc[2][4];
#pragma unroll
      for (int m = 0; m < 2; ++m)
#pragma unroll
          for (int nb = 0; nb < 4; ++nb) acc[m][nb] = (f32x4){0.f, 0.f, 0.f, 0.f};
      const bf16_t* wt = a.wpool_t + (size_t)g * 128 * 128 + (size_t)(nh * 64 + fr) * 128 + fq * 8;
#pragma unroll
      for (int ks = 0; ks < 4; ++ks) { bf16x8 af[2], bfr[4];
#pragma unroll
          for (int m = 0; m < 2; ++m) af[m] = *(const LAS bf16x8*)(ab + (m * 16 + fr) * AB_STRIDE + (g * 128 + ks * 32 + fq * 8) * 2);
#pragma unroll
          for (int nb = 0; nb < 4; ++nb) bfr[nb] = *(const bf16x8*)(wt + (size_t)nb * 16 * 128 + ks * 32);
#pragma unroll
          for (int m = 0; m < 2; ++m)
#pragma unroll
              for (int nb = 0; nb < 4; ++nb) acc[m][nb] = __builtin_amdgcn_mfma_f32_16x16x32_bf16(bfr[nb], af[m], acc[m][nb], 0, 0, 0); }
#pragma unroll
      for (int nb = 0; nb < 4; ++nb) { const int n = g * 128 + nh * 64 + nb * 16 + fq * 4; const f32x4 ps = *(const f32x4*)(a.pool_scale + n);
#pragma unroll
          for (int m = 0; m < 2; ++m) { const size_t row = (size_t)row0 + m * 16 + fr;
              const u32x2 gw = *(const u32x2*)(P + row * N_IN + C_GP + n);
              const float g0 = __uint_as_float(gw.x << 16), g1 = __uint_as_float(gw.x & 0xffff0000u), g2 = __uint_as_float(gw.y << 16), g3 = __uint_as_float(gw.y & 0xffff0000u);
              const f32x4 v = acc[m][nb] * ps;
              u32x2 w; w.x = pk2(v[0] * silu_f(g0), v[1] * silu_f(g1)); w.y = pk2(v[2] * silu_f(g2), v[3] * silu_f(g3));
              *(u32x2*)(a.Y + row * DM + 1024 + n) = w; } }
    }
    { const int c = tid; float y[TT], w[31];
#pragma unroll
      for (int j = 0; j < 31; ++j) w[j] = a.w_dw[j * 512 + c];
      const float bias = a.b_dw[c];
#pragma unroll
      for (int tk = 0; tk < TT; ++tk) y[tk] = bias;
      const bf16_t* cp = P + (size_t)seq0 * N_IN + C_CA + c;
#pragma unroll
      for (int p = 0; p < TT + 30; ++p) { const int tl = tl0 - 15 + p; float u = 0.f;
          if (tl >= 0 && tl < L) { const float av = bf2f(cp[(size_t)tl * N_IN]), bv = bf2f(cp[(size_t)tl * N_IN + 512]); u = av * sigm_f(bv); }
#pragma unroll
          for (int tk = 0; tk < TT; ++tk) { const int j = p - tk; if (j >= 0 && j < 31) y[tk] += u * w[j]; } }
#pragma unroll
      for (int tk = 0; tk < TT; ++tk) ys[tk * 512 + c] = y[tk]; }
    __syncthreads();
#pragma unroll
    for (int q = 0; q < 4; ++q) { const int tk = wid * 4 + q; float v[8], s = 0.f;
#pragma unroll
        for (int j = 0; j < 8; ++j) { v[j] = ys[tk * 512 + lane + 64 * j]; s += v[j]; }
        const float mu = wave_sum(s) * (1.f / 512.f); float qq = 0.f;
#pragma unroll
        for (int j = 0; j < 8; ++j) { v[j] -= mu; qq += v[j] * v[j]; }
        const float rs = rsqrtf(wave_sum(qq) * (1.f / 512.f) + EPS);
#pragma unroll
        for (int j = 0; j < 8; ++j) { const int c = lane + 64 * j; const float z = v[j] * rs * a.ln_g[c] + a.ln_b[c];
            *(LAS bf16_t*)(ab + tk * AB_STRIDE + c * 2) = (bf16_t)f2bf(silu_f(z)); } }
    __syncthreads();
    {
      f32x4 acc[2][4];
#pragma unroll
      for (int m = 0; m < 2; ++m)
#pragma unroll
          for (int nb = 0; nb < 4; ++nb) acc[m][nb] = (f32x4){0.f, 0.f, 0.f, 0.f};
      const bf16_t* wt = a.wpw2_t + (size_t)(wid * 64 + fr) * 512 + fq * 8;
#pragma unroll 2
      for (int ks = 0; ks < 16; ++ks) { bf16x8 af[2], bfr[4];
#pragma unroll
          for (int m = 0; m < 2; ++m) af[m] = *(const LAS bf16x8*)(ab + (m * 16 + fr) * AB_STRIDE + (ks * 32 + fq * 8) * 2);
#pragma unroll
          for (int nb = 0; nb < 4; ++nb) bfr[nb] = *(const bf16x8*)(wt + (size_t)nb * 16 * 512 + ks * 32);
#pragma unroll
          for (int m = 0; m < 2; ++m)
#pragma unroll
              for (int nb = 0; nb < 4; ++nb) acc[m][nb] = __builtin_amdgcn_mfma_f32_16x16x32_bf16(bfr[nb], af[m], acc[m][nb], 0, 0, 0); }
#pragma unroll
      for (int nb = 0; nb < 4; ++nb) { const int n = wid * 64 + nb * 16 + fq * 4;
#pragma unroll
          for (int m = 0; m < 2; ++m) { const size_t row = (size_t)row0 + m * 16 + fr;
              const u32x2 gw = *(const u32x2*)(P + row * N_IN + C_GC + n);
              const float g0 = __uint_as_float(gw.x << 16), g1 = __uint_as_float(gw.x & 0xffff0000u), g2 = __uint_as_float(gw.y << 16), g3 = __uint_as_float(gw.y & 0xffff0000u);
              const f32x4 v = acc[m][nb];
              u32x2 w; w.x = pk2(v[0] * silu_f(g0), v[1] * silu_f(g1)); w.y = pk2(v[2] * silu_f(g2), v[3] * silu_f(g3));
              *(u32x2*)(a.Y + row * DM + 1536 + n) = w; } }
    }
    __syncthreads();
}
}

#define XB_TMO      128
#define XB_XCNT(j)  (256  + 64 * (j))
#define XB_XSUB(j)  (1280 + 64 * (j))
#define XB_XGEN(j)  (2304 + 64 * (j))
#define XB_TOP      3328
#define XB_TOPGEN   3392
#define XCD_BAR_WORDS 3456
#define XB_SPIN_CAP (1u << 18)
__device__ __forceinline__ unsigned xb_ld(unsigned* p)              { return __hip_atomic_load(p, __ATOMIC_RELAXED, __HIP_MEMORY_SCOPE_AGENT); }
__device__ __forceinline__ unsigned xb_add(unsigned* p, unsigned v) { return __hip_atomic_fetch_add(p, v, __ATOMIC_RELAXED, __HIP_MEMORY_SCOPE_AGENT); }
__device__ __forceinline__ unsigned xb_xcc_id() { return (unsigned)__builtin_amdgcn_s_getreg((3 << 11) | 20) & 0xFu; }
#define XB_SPIN(cond, bar) do { unsigned _sp = 0; while (cond) { __builtin_amdgcn_s_sleep(1); \
    if ((++_sp & 255u) == 0u) { if (xb_ld(&(bar)[XB_TMO])) break; if (_sp > XB_SPIN_CAP) { atomicAdd(&(bar)[XB_TMO], 1u); break; } } } } while (0)
struct XcdBarrier { unsigned* bar; unsigned x; volatile LAS unsigned* st; };
__device__ __forceinline__ XcdBarrier xcd_barrier_post(unsigned* bar, volatile LAS unsigned* st) {
    XcdBarrier b; b.bar = bar; b.x = xb_xcc_id(); b.st = st;
    if (threadIdx.x == 0) (void)xb_add(&bar[XB_XCNT(b.x)], 1u);
    return b;
}
__device__ __forceinline__ void xcd_barrier_complete(unsigned* bar, unsigned x, unsigned& nloc, unsigned& nx) {
    const unsigned G = gridDim.x * gridDim.y * gridDim.z;
    unsigned sum, cnt, mine, sp = 0u;
    for (;;) {
        sum = 0u; cnt = 0u; mine = 0u;
#pragma unroll
        for (unsigned j = 0; j < 16; ++j) { const unsigned c = xb_ld(&bar[XB_XCNT(j)]); sum += c; cnt += (c > 0u) ? 1u : 0u; mine = (j == x) ? c : mine; }
        if (sum == G) break;
        __builtin_amdgcn_s_sleep(1);
        if ((++sp & 255u) == 0u) { if (xb_ld(&bar[XB_TMO])) break; if (sp > XB_SPIN_CAP) { atomicAdd(&bar[XB_TMO], 1u); break; } }
    }
    nloc = mine > 0u ? mine : 1u; nx = cnt > 0u ? cnt : 1u;
}
__device__ __forceinline__ void xcd_barrier(const XcdBarrier& b) {
    asm volatile("s_waitcnt vmcnt(0)" ::: "memory");
    __syncthreads();
    if (threadIdx.x == 0) {
        unsigned* bar = b.bar;
        __builtin_amdgcn_s_waitcnt(0);
        unsigned nloc = b.st[0], nx = b.st[1];
        if (nloc == 0u) { xcd_barrier_complete(bar, b.x, nloc, nx); b.st[0] = nloc; b.st[1] = nx; }
        const unsigned old = xb_add(&bar[XB_XSUB(b.x)], 1u);
        const unsigned gen = old / nloc;
        if (old + 1u == (gen + 1u) * nloc) {
            __builtin_amdgcn_fence(__ATOMIC_RELEASE, "agent");
            asm volatile("s_waitcnt vmcnt(0)" ::: "memory");
            const unsigned og = xb_add(&bar[XB_TOP], 1u);
            const unsigned tg = og / nx;
            if (og + 1u == (tg + 1u) * nx) xb_add(&bar[XB_TOPGEN], 1u);
            else XB_SPIN(xb_ld(&bar[XB_TOPGEN]) == tg, bar);
            __builtin_amdgcn_fence(__ATOMIC_ACQUIRE, "agent");
            xb_add(&bar[XB_XGEN(b.x)], 1u);
            asm volatile("s_waitcnt vmcnt(0)" ::: "memory");
        } else {
            XB_SPIN(xb_ld(&bar[XB_XGEN(b.x)]) == gen, bar);
            __builtin_amdgcn_fence(__ATOMIC_ACQUIRE, "agent");
            asm volatile("s_waitcnt vmcnt(0)" ::: "memory");
        }
    }
    __syncthreads();
}

__device__ __forceinline__ void p0_transpose_item(const float* W, int K, int N, bf16_t* WT, LAS float* scr, int item, int lane) {
    const int nblk = N / 32, kb = item / nblk, nb = item % nblk, k0 = 64 * kb, n0 = 32 * nb;
#pragma unroll 8
    for (int i = 0; i < 32; ++i) { const int kk = 2 * i + (lane >> 5); scr[kk * 33 + (lane & 31)] = W[(size_t)(k0 + kk) * N + n0 + (lane & 31)]; }
    asm volatile("s_waitcnt lgkmcnt(0)" ::: "memory");
    const int c = lane & 7;
#pragma unroll
    for (int j = 0; j < 4; ++j) { const int n = (lane >> 3) + 8 * j; const LAS float* s = scr + (8 * c) * 33 + n;
        u32x4 o; o.x = pk2(s[0 * 33], s[1 * 33]); o.y = pk2(s[2 * 33], s[3 * 33]); o.z = pk2(s[4 * 33], s[5 * 33]); o.w = pk2(s[6 * 33], s[7 * 33]);
        *(u32x4*)(WT + (size_t)(n0 + n) * K + k0 + 8 * c) = o; }
    asm volatile("s_waitcnt lgkmcnt(0)" ::: "memory");
}

struct Args {
    const float* in[22]; float* out; unsigned char* ws; int ph_lo, ph_hi;
};

__device__ __forceinline__ void norm_row(const float* __restrict__ xsrc, const float* __restrict__ csrc, const float* __restrict__ g, const float* __restrict__ MODl, bf16_t* __restrict__ H, int row, int lane) {
    const int b = row / TPB, t = row % TPB; const bool isctx = t < CTX;
    const float* src = isctx ? csrc + ((size_t)b * CTX + t) * DM : xsrc + ((size_t)b * SEQ + (t - CTX)) * DM;
    const float* mod = MODl + (size_t)(isctx ? 4 : b) * N_MOD;
    f32x4 v[8]; float ss = 0.f;
#pragma unroll
    for (int j = 0; j < 8; ++j) { v[j] = ((const f32x4*)src)[lane + 64 * j]; ss += (v[j][0] * v[j][0] + v[j][1] * v[j][1]) + (v[j][2] * v[j][2] + v[j][3] * v[j][3]); }
    ss = wave_sum(ss);
    const float rstd = rsqrtf(ss * (1.f / DM) + EPS);
#pragma unroll
    for (int j = 0; j < 8; ++j) { const int col = (lane + 64 * j) * 4;
        const f32x4 gg = *(const f32x4*)(g + col), sh = *(const f32x4*)(mod + col), sc = *(const f32x4*)(mod + 2048 + col);
        const f32x4 o = v[j] * rstd * gg * (sc + 1.f) + sh;
        u32x2 w; w.x = pk2(o[0], o[1]); w.y = pk2(o[2], o[3]);
        *(u32x2*)(H + (size_t)row * DM + col) = w; }
}

__global__ void __launch_bounds__(NTHREADS, 2) mega_fwd(Args args) {
    extern __shared__ __attribute__((aligned(16))) unsigned char lds_raw[];
    LAS unsigned char* lds = (LAS unsigned char*)lds_raw;
    const int G = gridDim.x, bx = blockIdx.x; const int vcu = (G % 8 == 0) ? (bx % 8) * (G / 8) + bx / 8 : bx;
    unsigned char* ws = args.ws;
    unsigned* ctl = (unsigned*)(ws + WS_CTL);
    const float* x = args.in[0]; const float* c_in = args.in[1]; const float* ctx = args.in[2]; const float* c_ctx = args.in[3];
    const float* w_mod = args.in[4]; const float* b_mod = args.in[5]; const float* norm_g = args.in[6]; const float* w_in = args.in[7];
    const float* subln_g = args.in[12]; const float* w_pool = args.in[13]; const float* pool_scale = args.in[14]; const float* w_dw = args.in[15];
    const float* b_dw = args.in[16]; const float* ln_g = args.in[17]; const float* ln_b = args.in[18]; const float* w_pw2 = args.in[19];
    const float* w_out = args.in[20]; const float* final_g = args.in[21];
    float* out = args.out;
    float* ROPE = (float*)(ws + WS_ROPE); float* MOD = (float*)(ws + WS_MOD);
    bf16_t* WIN = (bf16_t*)(ws + WS_WIN); bf16_t* WOUT = (bf16_t*)(ws + WS_WOUT); bf16_t* WPW2 = (bf16_t*)(ws + WS_WPW2); bf16_t* WPOOL = (bf16_t*)(ws + WS_WPOOL);
    float* CTXRES = (float*)(ws + WS_CTXRES); bf16_t* H = (bf16_t*)(ws + WS_H); bf16_t* P = (bf16_t*)(ws + WS_P); bf16_t* Y = (bf16_t*)(ws + WS_YMIX);

#if MK_USE_CG
    cg::grid_group grid = cg::this_grid();
#define SEAM() do { __syncthreads(); grid.sync(); } while (0)
#else
    for (int u = threadIdx.x; u < (LDS_BYTES - LDSCTL_OFF) / 4; u += NTHREADS) ((LAS unsigned*)(lds + LDSCTL_OFF))[u] = 0u;
    __syncthreads();
    XcdBarrier bar = xcd_barrier_post(ctl + CW_BAR, (volatile LAS unsigned*)(lds + MISC_OFF) + 8);
#define SEAM() xcd_barrier(bar)
#endif
    const int lo = args.ph_lo, hi = args.ph_hi;
#define IN(k) (lo <= (k) && (k) < hi)
#define BOTH(k) (IN(k) && IN((k) + 1))
    const int NGW = G * NWAVES;
#define PHASE_IDS() const int tid = opaque_tid(), lane = tid & 63, wave = __builtin_amdgcn_readfirstlane(tid >> 6), gw = vcu * NWAVES + wave; (void)gw; (void)lane

    if (IN(0)) {
        PHASE_IDS();
        constexpr int N_MODITEMS = 2 * (N_MOD / 64);
        constexpr int I_WIN = (DM / 64) * (N_IN / 32), I_WOUT = (DM / 64) * (DM / 32), I_PW2 = (512 / 64) * (512 / 32), I_POOL = (128 / 64) * (128 / 32);
        constexpr int N_TR = 2 * I_WIN + 2 * I_WOUT + 2 * I_PW2 + 8 * I_POOL;
        constexpr int N_BITEMS = N_MODITEMS + 1 + (N_TR + 7) / 8;
        for (int it = bx; it < N_BITEMS; it += G) {
            if (it < N_MODITEMS) {
                const int l = it / (N_MOD / 64), cgp = it % (N_MOD / 64);
                LAS float* s = (LAS float*)lds; LAS float* red = (LAS float*)(lds + 5 * 2048 * 4);
                for (int i = tid; i < 5 * 2048; i += NTHREADS) { const int r = i >> 11, k = i & 2047; const float v = r < 4 ? c_in[r * 2048 + k] : c_ctx[k]; s[i] = v / (1.f + expf(-v)); }
                __syncthreads();
                float acc[5] = {0.f, 0.f, 0.f, 0.f, 0.f};
                const float* W = w_mod + (size_t)l * DM * N_MOD + cgp * 64 + lane;
#pragma unroll 8
                for (int k = wave * 256; k < wave * 256 + 256; ++k) { const float w = W[(size_t)k * N_MOD];
#pragma unroll
                    for (int r = 0; r < 5; ++r) acc[r] += s[r * 2048 + k] * w; }
#pragma unroll
                for (int r = 0; r < 5; ++r) red[(wave * 5 + r) * 64 + lane] = acc[r];
                __syncthreads();
                if (tid < 320) { const int r = tid >> 6, ln = tid & 63; float v = b_mod[l * N_MOD + cgp * 64 + ln];
#pragma unroll
                    for (int w8 = 0; w8 < 8; ++w8) v += red[(w8 * 5 + r) * 64 + ln];
                    MOD[((size_t)l * 5 + r) * N_MOD + cgp * 64 + ln] = v; }
                __syncthreads();
            } else if (it == N_MODITEMS) {
                for (int i = tid; i < 64 * 16; i += NTHREADS) { const int pos = i >> 4, fi = i & 15; const float inv = powf(10000.f, -(float)fi / 16.f), ang = (float)pos * inv;
                    ROPE[i * 2] = cosf(ang); ROPE[i * 2 + 1] = sinf(ang); }
                if (tid < 2) { const int l = tid; float a = 0.f, b = 0.f;
                    for (int i = 0; i < 64; ++i) { a += args.in[8][l * 64 + i] * args.in[9][l * 64 + i]; b += args.in[10][l * 64 + i] * args.in[11][l * 64 + i]; }
                    const float lam_init = 0.8f - 0.6f * expf(-0.3f * (float)l);
                    MOD[2 * 5 * N_MOD + l] = expf(a) - expf(b) + lam_init; }
            } else {
                LAS float* scr = (LAS float*)(lds + wave * 16384);
                int r = (it - N_MODITEMS - 1) * 8 + wave;
                if (r < N_TR) {
                    if (r < 2 * I_WIN) { const int l = r / I_WIN; p0_transpose_item(w_in + (size_t)l * DM * N_IN, DM, N_IN, WIN + (size_t)l * DM * N_IN, scr, r % I_WIN, lane); }
                    else if ((r -= 2 * I_WIN) < 2 * I_WOUT) { const int l = r / I_WOUT; p0_transpose_item(w_out + (size_t)l * DM * DM, DM, DM, WOUT + (size_t)l * DM * DM, scr, r % I_WOUT, lane); }
                    else if ((r -= 2 * I_WOUT) < 2 * I_PW2) { const int l = r / I_PW2; p0_transpose_item(w_pw2 + (size_t)l * 512 * 512, 512, 512, WPW2 + (size_t)l * 512 * 512, scr, r % I_PW2, lane); }
                    else { r -= 2 * I_PW2; const int lg = r / I_POOL; p0_transpose_item(w_pool + (size_t)lg * 128 * 128, 128, 128, WPOOL + (size_t)lg * 128 * 128, scr, r % I_POOL, lane); }
                }
            }
        }
        if (BOTH(0)) SEAM();
    }

#pragma unroll 1
    for (int l = 0; l < DEPTH; ++l) {
        const float* MODl = MOD + (size_t)l * 5 * N_MOD;
        const float* xsrc = l == 0 ? x : out; const float* csrc = l == 0 ? ctx : CTXRES;
        const bool last = (l == DEPTH - 1);
        if (IN(1 + 4 * l)) {
            PHASE_IDS();
            for (int row = gw; row < M_TOT; row += NGW) norm_row(xsrc, csrc, norm_g + l * DM, MODl, H, row, lane);
            if (BOTH(1 + 4 * l)) SEAM();
        }
        if (IN(2 + 4 * l)) {
            pg8::Gemm g{H, WIN + (size_t)l * DM * N_IN, M_TOT, N_IN, DM};
            pg8::TileSched S; if (!last) S.init(36, N_IN / 256, 0, 0, G, bx); else S.init(32, N_IN / 256, 32, 1, G, bx);
            pg8::EpiIn E{P, ROPE};
            pg8::gemm_phase<pg8::EpiIn, pg8::TileSched, true, true>(lds, g, S, E);
            if (BOTH(2 + 4 * l)) SEAM();
        }
        if (IN(3 + 4 * l)) {
            const float lam = MOD[2 * 5 * N_MOD + l], lam_init = 0.8f - 0.6f * expf(-0.3f * (float)l), osc = 1.f - lam_init;
            { mixu::Args ma{P, Y, WPOOL + (size_t)l * 4 * 128 * 128, pool_scale + l * 512, w_dw + (size_t)l * 31 * 512, b_dw + l * 512, ln_g + l * 512, ln_b + l * 512, WPW2 + (size_t)l * 512 * 512};
              const int ntiles = last ? BATCH * SEQ / 32 : M_TOT / 32;
              for (int t = vcu; t < ntiles; t += G) { int row0;
                  if (last) row0 = (t / 64) * TPB + CTX + (t % 64) * 32; else row0 = t * 32;
                  mixu::mix_unit(ma, row0, lds); } }
            { constexpr int NUL = BATCH * HEADS * (SEQ / 128), NUC = BATCH * HEADS * (CTX / 128); const int upc = (NUL + G - 1) / G, ncx = last ? 0 : (NUC + G - 1) / G;
              for (int i = 0; i < upc + ncx; ++i) {
                  int qrow0, krow0, nkeys, h;
                  if (i < upc) { const int id = vcu * upc + i; if (id >= NUL) continue;
                      const int bh = id / (SEQ / 128), qb = id % (SEQ / 128), b = bh / HEADS; h = bh % HEADS; qrow0 = b * TPB + CTX + qb * 128; krow0 = b * TPB; nkeys = TPB; }
                  else { const int id = vcu + (i - upc) * G; if (id >= NUC) continue;
                      const int bh = id / (CTX / 128), qb = id % (CTX / 128), b = bh / HEADS; h = bh % HEADS; qrow0 = b * TPB + qb * 128; krow0 = b * TPB; nkeys = CTX; }
                  att::attn_unit(P, Y, qrow0, krow0, nkeys, h, lam, osc, subln_g + l * 128, (char*)lds_raw); } }
            if (BOTH(3 + 4 * l)) SEAM();
        }
        if (IN(4 + 4 * l)) {
            pg8::Gemm g{Y, WOUT + (size_t)l * DM * DM, M_TOT, DM, DM};
            pg8::TileSched S; if (!last) S.init(36, DM / 256, 0, 0, G, bx); else S.init(32, DM / 256, 0, 1, G, bx);
            pg8::EpiOut E{xsrc, csrc, out, CTXRES, MODl};
            pg8::gemm_phase<pg8::EpiOut, pg8::TileSched, true, true>(lds, g, S, E);
            if (BOTH(4 + 4 * l)) SEAM();
        }
    }
    if (IN(9)) {
        PHASE_IDS();
        for (int row = gw; row < BATCH * SEQ; row += NGW) {
            f32x4* p = (f32x4*)(out + (size_t)row * DM); f32x4 v[8]; float ss = 0.f;
#pragma unroll
            for (int j = 0; j < 8; ++j) { v[j] = p[lane + 64 * j]; ss += (v[j][0] * v[j][0] + v[j][1] * v[j][1]) + (v[j][2] * v[j][2] + v[j][3] * v[j][3]); }
            const float rstd = rsqrtf(wave_sum(ss) * (1.f / DM) + EPS);
#pragma unroll
            for (int j = 0; j < 8; ++j) { const f32x4 gg = *(const f32x4*)(final_g + (lane + 64 * j) * 4); p[lane + 64 * j] = v[j] * rstd * gg; }
        }
    }
#undef IN
#undef BOTH
#undef SEAM
}

extern "C" void kernel_launch(void* const* d_in, const int* in_sizes, int n_in, void* d_out, int out_size, void* d_ws, size_t ws_size, hipStream_t stream) {
    static int grid = 0;
    if (grid == 0) {
        if (n_in != 22 || ws_size < WS_END || out_size != BATCH * SEQ * DM) { fprintf(stderr, "kernel_launch: unexpected n_in %d / out %d / ws %zu\n", n_in, out_size, ws_size); grid = -1; return; }
        int dev = 0, cus = 0, per_cu = 0;
        if (hipGetDevice(&dev) != hipSuccess || hipDeviceGetAttribute(&cus, hipDeviceAttributeMultiprocessorCount, dev) != hipSuccess) { grid = -1; return; }
        if (hipFuncSetAttribute((const void*)mega_fwd, hipFuncAttributeMaxDynamicSharedMemorySize, LDS_BYTES) != hipSuccess) { fprintf(stderr, "kernel_launch: hipFuncSetAttribute failed\n"); grid = -1; return; }
        if (hipOccupancyMaxActiveBlocksPerMultiprocessor(&per_cu, (const void*)mega_fwd, NTHREADS, LDS_BYTES) != hipSuccess || per_cu < 1) { fprintf(stderr, "kernel_launch: occupancy query says %d blocks per CU\n", per_cu); grid = -1; return; }
        (void)hipGetLastError();
        grid = cus;
    }
    if (grid < 0) return;
    (void)hipMemsetAsync((char*)d_ws + WS_CTL, 0, CTL_ZERO_BYTES, stream);
    Args a{};
    for (int i = 0; i < 22; ++i) a.in[i] = (const float*)d_in[i];
    a.out = (float*)d_out; a.ws = (unsigned char*)d_ws;
#if MK_PER_PHASE
    for (int ph = 0; ph < 10; ++ph) { a.ph_lo = ph; a.ph_hi = ph + 1;
        void* kargs[] = {&a};
        hipError_t e = hipLaunchCooperativeKernel((void*)mega_fwd, dim3(grid), dim3(NTHREADS), kargs, LDS_BYTES, stream);
        if (e != hipSuccess) { fprintf(stderr, "kernel_launch: launch failed: %s\n", hipGetErrorString(e)); break; } }
#else
    a.ph_lo = 0; a.ph_hi = 10;
    void* kargs[] = {&a};
    hipError_t e = hipLaunchCooperativeKernel((void*)mega_fwd, dim3(grid), dim3(NTHREADS), kargs, LDS_BYTES, stream);
    if (e != hipSuccess) fprintf(stderr, "kernel_launch: cooperative launch failed: %s (grid %d)\n", hipGetErrorString(e), grid);
#endif
}
```

```cpp
#include <hip/hip_runtime.h>
#include <hip/hip_cooperative_groups.h>
#include <cstdint>
#include <cstdio>
#include <cmath>
namespace cg = cooperative_groups;

#ifndef MK_USE_CG
#define MK_USE_CG 0
#endif
#ifndef MK_PER_PHASE
#define MK_PER_PHASE 0
#endif

constexpr int DM = 2048, BATCH = 4, SEQ = 2048, DEPTH = 2, CTX = 256;
constexpr int N_IN = 6656, N_MOD = 6144, HEADS = 8;
constexpr int TPB = CTX + SEQ;
constexpr int M_TOT = BATCH * TPB;
constexpr float EPS = 1e-6f;
constexpr int C_Q = 0, C_K = 1024, C_V = 2048, C_GA = 3072, C_UP = 4096, C_GP = 4608, C_CA = 5120, C_CB = 5632, C_GC = 6144;
constexpr int NWAVES = 8, NTHREADS = 512;

#define LAS __attribute__((address_space(3)))
#define GAS __attribute__((address_space(1)))
typedef unsigned short bf16_t;
typedef short bf16x8 __attribute__((ext_vector_type(8)));
typedef short s16x4 __attribute__((ext_vector_type(4)));
typedef float f32x4 __attribute__((ext_vector_type(4)));
typedef float f32x16 __attribute__((ext_vector_type(16)));
typedef unsigned u32x4 __attribute__((ext_vector_type(4)));
typedef unsigned u32x2 __attribute__((ext_vector_type(2)));

__device__ __forceinline__ float bf2f(bf16_t v) { return __uint_as_float(((unsigned)v) << 16); }
__device__ __forceinline__ unsigned f2bf(float f) { unsigned u = __float_as_uint(f); return (u + 0x7fffu + ((u >> 16) & 1u)) >> 16; }
__device__ __forceinline__ unsigned pk2(float lo, float hi) { return f2bf(lo) | (f2bf(hi) << 16); }
__device__ __forceinline__ unsigned cvt_pk_bf16(float lo, float hi) { unsigned r; asm volatile("v_cvt_pk_bf16_f32 %0, %1, %2" : "=v"(r) : "v"(lo), "v"(hi)); return r; }
__device__ __forceinline__ float silu_f(float v) { return v * __builtin_amdgcn_rcpf(1.f + __expf(-v)); }
__device__ __forceinline__ float sigm_f(float v) { return __builtin_amdgcn_rcpf(1.f + __expf(-v)); }
__device__ __forceinline__ float wave_sum(float v) {
#pragma unroll
    for (int o = 1; o < 64; o <<= 1) v += __shfl_xor(v, o);
    return v;
}

__device__ __forceinline__ int opaque_tid() { int t = threadIdx.x; asm volatile("" : "+v"(t)); return t; }

constexpr size_t MiB = 1u << 20;
constexpr size_t WS_CTL = 0, CTL_ZERO_BYTES = 64 * 1024;
constexpr size_t WS_ROPE = 512 * 1024;
constexpr size_t WS_MOD = 1 * MiB;
constexpr size_t WS_WIN = 2 * MiB;
constexpr size_t WS_WOUT = 54 * MiB;
constexpr size_t WS_WPW2 = 70 * MiB;
constexpr size_t WS_WPOOL = 71 * MiB;
constexpr size_t WS_CTXRES = 72 * MiB;
constexpr size_t WS_H = 80 * MiB;
constexpr size_t WS_P = 116 * MiB;
constexpr size_t WS_YMIX = 234 * MiB;
constexpr size_t WS_END = 270 * MiB;
constexpr int CW_BAR = 1024;

constexpr int RING_BYTES = 131072;
constexpr int LDSCTL_OFF = RING_BYTES, MISC_OFF = LDSCTL_OFF + 320;
constexpr int LDS_BYTES = 147456;

namespace pg8 {
constexpr int BM = 256, BK = 64, HALF = 128, HTB = HALF * BK * 2, STAGE_BYTES = 8 * HTB, NXCD = 8, WGM = 8;
__host__ __device__ __forceinline__ int lds_byte(int r, int c) { const int st = (r >> 4) * 2 + (c >> 5), rr = r & 15, cc = c & 31, ob = rr * 64 + cc * 2; return st * 1024 + (ob ^ (((ob >> 9) & 1) << 5)); }
__host__ __device__ __forceinline__ void stage_rc(int b, int& R, int& C) { const int st = b / 1024, sb = b % 1024, swz = sb ^ (((sb >> 9) & 1) << 5); R = (st >> 1) * 16 + swz / 64; C = (st & 1) * 32 + (swz % 64) / 2; }
__host__ __device__ __forceinline__ int perm32(int rho) { const int n = rho >> 4, i = rho & 15; return 8 * (i >> 2) + 4 * n + (i & 3); }

struct Unit { int pm, pn; };
struct Gemm { const bf16_t* A; const bf16_t* Bt; int M, N, K; };

struct TileSched {
    int nM, nN, nreg, nwg, G, c, lat_only;
    __device__ void init(int nM_, int nN_, int nextra, int lat_only_, int G_, int c_) { nM = nM_; nN = nN_; nreg = nM_ * nN_; nwg = nreg + nextra; lat_only = lat_only_; G = G_; c = c_; }
    __device__ bool next(int i, Unit& u) const {
        const long L = (long)i * G + c; if (L >= nwg) return false;
        int wgid = (int)L; { const int q = nwg / NXCD, r = nwg % NXCD, xcd = wgid % NXCD, off = wgid / NXCD; wgid = (xcd < r ? xcd * (q + 1) : r * (q + 1) + (xcd - r) * q) + off; }
        if (wgid < nreg) {
            const int nig = WGM * nN, gid = wgid / nig, fm = gid * WGM, gsz = (nM - fm) < WGM ? (nM - fm) : WGM;
            const int j = fm + ((wgid % nig) % gsz); u.pn = (wgid % nig) / gsz;
            u.pm = lat_only ? (j >> 3) * 9 + 1 + (j & 7) : j;
        } else { const int e = wgid - nreg; u.pm = (e >> 3) * 9; u.pn = 4 + (e & 7); }
        return true;
    }
    __device__ __forceinline__ void a_ready(const Unit&) const {}
    __device__ __forceinline__ void done(const Unit&) const {}
};

struct EpiIn {
    static constexpr bool PERM = false, AFTER_DRAIN = false;
    bf16_t* P; const float* rope;
    __device__ __forceinline__ void operator()(const f32x4 (&acc)[2][2][4][2], const Unit& u, int wr, int wc, int fr, int fq) const {
        const int bt = u.pm % 9; const bool do_rope = (u.pn < 8) && (bt != 0);
        const int col0 = u.pn * BM + wc * 32 + 4 * fq;
#pragma unroll
        for (int ai = 0; ai < 2; ++ai)
#pragma unroll
            for (int m = 0; m < 4; ++m) {
                const int rl = ai * HALF + wr * 64 + m * 16 + fr; const size_t row = (size_t)u.pm * BM + rl;
                f32x4 cs = {1.f, 1.f, 1.f, 1.f}, sn = {0.f, 0.f, 0.f, 0.f};
                if (do_rope) { const int tl = (bt - 1) * 256 + rl, pos = (wc & 1) ? (tl & 63) : (tl >> 6);
                    const f32x4 a = *(const f32x4*)(rope + (pos * 16 + 4 * fq) * 2), b = *(const f32x4*)(rope + (pos * 16 + 4 * fq) * 2 + 4);
                    cs = (f32x4){a[0], a[2], b[0], b[2]}; sn = (f32x4){a[1], a[3], b[1], b[3]}; }
                bf16_t* rowp = P + row * N_IN + col0;
#pragma unroll
                for (int bj = 0; bj < 2; ++bj) { const f32x4 v0 = acc[ai][bj][m][0], v1 = acc[ai][bj][m][1];
                    const f32x4 o0 = v0 * cs - v1 * sn, o1 = v1 * cs + v0 * sn;
                    u32x2 w0, w1; w0.x = cvt_pk_bf16(o0[0], o0[1]); w0.y = cvt_pk_bf16(o0[2], o0[3]); w1.x = cvt_pk_bf16(o1[0], o1[1]); w1.y = cvt_pk_bf16(o1[2], o1[3]);
                    *(u32x2*)(rowp + bj * HALF) = w0; *(u32x2*)(rowp + bj * HALF + 16) = w1; }
            }
    }
};
struct EpiOut {
    static constexpr bool PERM = false, AFTER_DRAIN = false;
    const float* xin; const float* cin; float* xout; float* cout; const float* MODl;
    __device__ __forceinline__ void operator()(const f32x4 (&acc)[2][2][4][2], const Unit& u, int wr, int wc, int fr, int fq) const {
        const int bt = u.pm % 9, b = u.pm / 9; const bool lat = bt != 0;
        const int col0 = u.pn * BM + wc * 32 + 4 * fq;
        const float* gp = MODl + (size_t)(lat ? b : 4) * N_MOD + 4096 + col0;
        f32x4 gv[2][2];
#pragma unroll
        for (int bj = 0; bj < 2; ++bj)
#pragma unroll
            for (int n = 0; n < 2; ++n) gv[bj][n] = *(const f32x4*)(gp + bj * HALF + n * 16);
        const float* src = lat ? xin : cin; float* dst = lat ? xout : cout;
#pragma unroll
        for (int ai = 0; ai < 2; ++ai)
#pragma unroll
            for (int m = 0; m < 4; ++m) {
                const int rl = ai * HALF + wr * 64 + m * 16 + fr;
                const size_t off = (lat ? ((size_t)b * SEQ + (bt - 1) * 256 + rl) : ((size_t)b * CTX + rl)) * DM + col0;
#pragma unroll
                for (int bj = 0; bj < 2; ++bj)
#pragma unroll
                    for (int n = 0; n < 2; ++n) { const f32x4 old = *(const f32x4*)(src + off + bj * HALF + n * 16); *(f32x4*)(dst + off + bj * HALF + n * 16) = old + gv[bj][n] * acc[ai][bj][m][n]; }
            }
    }
};

template <class Epi, class Sched, bool ALIGN_EPI = false, bool SP2 = false>
__device__ __forceinline__ void gemm_phase(LAS unsigned char* lds, const Gemm g, const Sched& S, const Epi& E) {
    const int tid = opaque_tid(), wid = __builtin_amdgcn_readfirstlane(tid >> 6), lane = tid & 63, wr = wid >> 2, wc = wid & 3, fr = lane & 15, fq = lane >> 4;
    const int K = g.K, nt = K / BK;
    unsigned voffA[2], voffB[2];
#pragma unroll
    for (int i = 0; i < 2; ++i) { int R, C; stage_rc(tid * 16 + i * 8192, R, C); const int Rb = Epi::PERM ? ((R & ~31) + perm32(R & 31)) : R;
        voffA[i] = (unsigned)(R * K + C) * 2u; voffB[i] = (unsigned)(Rb * K + C) * 2u; }
    const size_t kstep = (size_t)(BK * 2);
    const size_t hstep = (size_t)HALF * K * 2;
    const size_t tstep = 2 * hstep;
    const unsigned ldsw = (unsigned)wid * 1024u;
    const int aoff = lds_byte(wr * 64 + fr, fq * 8), boff = lds_byte(wc * 32 + fr, fq * 8);
#define PG8_SA(b, h) (((b) * 2 + (h)) * HTB)
#define PG8_SB(b, h) ((4 + (b) * 2 + (h)) * HTB)
#define PG8_STAGE(bufoff, gbase, voff) do { _Pragma("unroll") for (int _i = 0; _i < 2; ++_i) \
        __builtin_amdgcn_global_load_lds((const unsigned*)((const char*)(gbase) + (voff)[_i]), (LAS unsigned*)(lds + (bufoff) + ldsw + _i * 8192), 16, 0, 0); } while (0)
#define PG8_LDA(dst, b, h) do { _Pragma("unroll") for (int m = 0; m < 4; ++m) _Pragma("unroll") for (int k = 0; k < 2; ++k) dst[m][k] = *(const LAS bf16x8*)(lds + PG8_SA(b, h) + aoff + m * 2048 + k * 1024); } while (0)
#define PG8_LDB(dst, b, h) do { _Pragma("unroll") for (int n = 0; n < 2; ++n) _Pragma("unroll") for (int k = 0; k < 2; ++k) dst[n][k] = *(const LAS bf16x8*)(lds + PG8_SB(b, h) + boff + n * 2048 + k * 1024); } while (0)
#define PG8_MMA(ai, bj, At, Bt) do { __builtin_amdgcn_s_setprio(1); _Pragma("unroll") for (int m = 0; m < 4; ++m) _Pragma("unroll") for (int n = 0; n < 2; ++n) _Pragma("unroll") for (int k = 0; k < 2; ++k) \
        acc[ai][bj][m][n] = __builtin_amdgcn_mfma_f32_16x16x32_bf16(Bt[n][k], At[m][k], acc[ai][bj][m][n], 0, 0, 0); __builtin_amdgcn_s_setprio(0); } while (0)
#define PG8_WAIT_V(n) asm volatile("s_waitcnt vmcnt(" #n ")" ::: "memory")
#define PG8_WAIT_L(n) asm volatile("s_waitcnt lgkmcnt(" #n ")" ::: "memory")
#define PG8_BAR __builtin_amdgcn_s_barrier()
#define PG8_SCHED __builtin_amdgcn_sched_barrier(0)
    Unit cur, nxt; int ui = 0;
    if (!S.next(0, cur)) return;
    f32x4 acc[2][2][4][2];
#pragma unroll
    for (int a = 0; a < 2; ++a)
#pragma unroll
        for (int b = 0; b < 2; ++b)
#pragma unroll
            for (int m = 0; m < 4; ++m)
#pragma unroll
                for (int n = 0; n < 2; ++n) acc[a][b][m][n] = (f32x4){0.f, 0.f, 0.f, 0.f};
    bf16x8 At[4][2], B0[2][2], B1[2][2];
    const char* cA = (const char*)g.A + (size_t)cur.pm * tstep; const char* cB = (const char*)g.Bt + (size_t)cur.pn * tstep;
    S.a_ready(cur);
    if constexpr (SP2) {
        PG8_STAGE(PG8_SB(0, 0), cB, voffB); PG8_STAGE(PG8_SB(0, 1), cB + hstep, voffB); PG8_STAGE(PG8_SA(0, 0), cA, voffA); PG8_STAGE(PG8_SA(0, 1), cA + hstep, voffA);
        if (wr == 1) PG8_BAR;
        PG8_WAIT_V(2); PG8_BAR;
        PG8_STAGE(PG8_SB(1, 0), cB + kstep, voffB); PG8_STAGE(PG8_SA(1, 0), cA + kstep, voffA); PG8_STAGE(PG8_SB(1, 1), cB + hstep + kstep, voffB);
        PG8_WAIT_V(6); PG8_BAR;
    } else {
        PG8_STAGE(PG8_SB(0, 0), cB, voffB); PG8_STAGE(PG8_SA(0, 0), cA, voffA); PG8_STAGE(PG8_SB(0, 1), cB + hstep, voffB); PG8_STAGE(PG8_SA(0, 1), cA + hstep, voffA);
        if (wr == 1) PG8_BAR;
        PG8_WAIT_V(4); PG8_BAR;
        PG8_STAGE(PG8_SB(1, 0), cB + kstep, voffB); PG8_STAGE(PG8_SA(1, 0), cA + kstep, voffA); PG8_STAGE(PG8_SB(1, 1), cB + hstep + kstep, voffB);
        PG8_WAIT_V(6); PG8_BAR;
    }
    for (;;) {
        const bool has_next = S.next(ui + 1, nxt);
        const char* nA = has_next ? (const char*)g.A + (size_t)nxt.pm * tstep : cA; const char* nB = has_next ? (const char*)g.Bt + (size_t)nxt.pn * tstep : cB;
        for (int t = 0; t < nt; t += 2) {
            const bool last = (t == nt - 2);
            const char* a1 = cA + (size_t)(t + 1) * kstep;
            const char* a2 = last ? nA : cA + (size_t)(t + 2) * kstep; const char* b2 = last ? nB : cB + (size_t)(t + 2) * kstep;
            const char* a3 = a2 + kstep; const char* b3 = b2 + kstep;
            if (last && has_next) S.a_ready(nxt);
            if constexpr (SP2) {
            PG8_LDB(B0, 0, 0); PG8_LDB(B1, 0, 1); PG8_SCHED; PG8_LDA(At, 0, 0); PG8_STAGE(PG8_SA(1, 1), a1 + hstep, voffA);
            PG8_WAIT_V(8); PG8_WAIT_L(0); PG8_BAR; PG8_MMA(0, 0, At, B0); PG8_MMA(0, 1, At, B1); PG8_BAR; PG8_SCHED;
            PG8_LDA(At, 0, 1); PG8_STAGE(PG8_SB(0, 0), b2, voffB); PG8_STAGE(PG8_SB(0, 1), b2 + hstep, voffB); PG8_STAGE(PG8_SA(0, 0), a2, voffA);
            PG8_WAIT_V(8); PG8_WAIT_L(0); PG8_BAR; PG8_MMA(1, 0, At, B0); PG8_MMA(1, 1, At, B1); PG8_BAR; PG8_SCHED;
            PG8_LDB(B0, 1, 0); PG8_LDB(B1, 1, 1); PG8_SCHED; PG8_LDA(At, 1, 0); PG8_STAGE(PG8_SA(0, 1), a2 + hstep, voffA);
            PG8_WAIT_V(8); PG8_WAIT_L(0); PG8_BAR; PG8_MMA(0, 0, At, B0); PG8_MMA(0, 1, At, B1); PG8_BAR; PG8_SCHED;
            PG8_LDA(At, 1, 1); PG8_STAGE(PG8_SB(1, 0), b3, voffB); PG8_STAGE(PG8_SB(1, 1), b3 + hstep, voffB); PG8_STAGE(PG8_SA(1, 0), a3, voffA);
            PG8_WAIT_V(8); PG8_WAIT_L(0); PG8_BAR; PG8_MMA(1, 0, At, B0); PG8_MMA(1, 1, At, B1); PG8_BAR; PG8_SCHED;
            } else {
            PG8_LDB(B0, 0, 0); PG8_SCHED; PG8_LDA(At, 0, 0); PG8_STAGE(PG8_SA(1, 1), a1 + hstep, voffA);
            PG8_WAIT_L(8); PG8_BAR; PG8_WAIT_L(0); PG8_MMA(0, 0, At, B0); PG8_BAR; PG8_SCHED;
            PG8_LDB(B1, 0, 1); PG8_STAGE(PG8_SB(0, 0), b2, voffB);
            PG8_BAR; PG8_WAIT_L(0); PG8_MMA(0, 1, At, B1); PG8_BAR;
            PG8_LDA(At, 0, 1); PG8_STAGE(PG8_SA(0, 0), a2, voffA);
            PG8_BAR; PG8_WAIT_L(0); PG8_MMA(1, 0, At, B0); PG8_BAR; PG8_SCHED;
            PG8_STAGE(PG8_SB(0, 1), b2 + hstep, voffB);
            PG8_WAIT_V(6); PG8_BAR; PG8_MMA(1, 1, At, B1); PG8_BAR;
            PG8_LDB(B0, 1, 0); PG8_SCHED; PG8_LDA(At, 1, 0); PG8_STAGE(PG8_SA(0, 1), a2 + hstep, voffA);
            PG8_WAIT_L(8); PG8_BAR; PG8_WAIT_L(0); PG8_MMA(0, 0, At, B0); PG8_BAR; PG8_SCHED;
            PG8_LDB(B1, 1, 1); PG8_STAGE(PG8_SB(1, 0), b3, voffB);
            PG8_BAR; PG8_WAIT_L(0); PG8_MMA(0, 1, At, B1); PG8_BAR;
            PG8_LDA(At, 1, 1); PG8_STAGE(PG8_SA(1, 0), a3, voffA);
            PG8_BAR; PG8_WAIT_L(0); PG8_MMA(1, 0, At, B0); PG8_BAR; PG8_SCHED;
            PG8_STAGE(PG8_SB(1, 1), b3 + hstep, voffB);
            PG8_WAIT_V(6); PG8_BAR; PG8_MMA(1, 1, At, B1); PG8_BAR;
            }
        }
        if constexpr (ALIGN_EPI) { if (wr == 0) PG8_BAR; }
        if constexpr (!Epi::AFTER_DRAIN) { E(acc, cur, wr, wc, fr, fq); S.done(cur); }
        if (!has_next) break;
#pragma unroll
        for (int a = 0; a < 2; ++a)
#pragma unroll
            for (int b = 0; b < 2; ++b)
#pragma unroll
                for (int m = 0; m < 4; ++m)
#pragma unroll
                    for (int n = 0; n < 2; ++n) acc[a][b][m][n] = (f32x4){0.f, 0.f, 0.f, 0.f};
        cur = nxt; cA = nA; cB = nB; ++ui;
        if constexpr (ALIGN_EPI) { if (wr == 1) PG8_BAR; }
    }
    PG8_WAIT_V(0);
    if constexpr (!ALIGN_EPI) { if (wr == 0) PG8_BAR; }
    PG8_BAR;
#undef PG8_SA
#undef PG8_SB
#undef PG8_STAGE
#undef PG8_LDA
#undef PG8_LDB
#undef PG8_MMA
#undef PG8_WAIT_V
#undef PG8_WAIT_L
#undef PG8_BAR
#undef PG8_SCHED
}
}

namespace att {
constexpr int KVBLK = 64;
constexpr int SHM_V = KVBLK * 128 * 2, SHM_K = KVBLK * 128 * 2;
constexpr int OFF_V = 0, OFF_K = 2 * SHM_V, OFF_WS = 2 * SHM_V + 2 * SHM_K, ATT_LDS = OFF_WS + NWAVES * 64 * 4;
constexpr float SCALE = 0.125f, THR = 8.f;
#define KSWZ(row, colB) ((row) * 256 + ((colB) ^ (((row) & 7) << 4)))
#define SBAR() __builtin_amdgcn_sched_barrier(0)
__device__ __forceinline__ int crow(int r, int hi) { return (r & 3) + 8 * (r >> 2) + 4 * hi; }
__device__ __forceinline__ void partialSM(f32x16& p0, f32x16& p1, float& m_reg, float& mn, float& alpha) {
    constexpr float C = SCALE * 1.4426950408889634f;
    float pmax = p0[0];
#pragma unroll
    for (int r = 1; r < 16; ++r) pmax = fmaxf(pmax, p0[r]);
#pragma unroll
    for (int r = 0; r < 16; ++r) pmax = fmaxf(pmax, p1[r]);
    { auto rr = __builtin_amdgcn_permlane32_swap(__float_as_uint(pmax), __float_as_uint(pmax), false, false);
      pmax = fmaxf(__uint_as_float(rr[0]), __uint_as_float(rr[1])); }
    if (__builtin_expect(__all(pmax - m_reg <= THR / SCALE), 1)) { mn = m_reg; alpha = 1.f; }
    else { mn = fmaxf(m_reg, pmax); alpha = __builtin_amdgcn_exp2f((m_reg - mn) * C); m_reg = mn; }
    const float mnC = -mn * C;
#pragma unroll
    for (int r = 0; r < 16; ++r) p0[r] = fmaf(p0[r], C, mnC);
#pragma unroll
    for (int r = 0; r < 16; ++r) p1[r] = fmaf(p1[r], C, mnC);
#pragma unroll
    for (int r = 0; r < 16; ++r) p0[r] = __builtin_amdgcn_exp2f(p0[r]);
}
__device__ __forceinline__ void finishSM(f32x16& p0, f32x16& p1, float alpha, float& l_reg, bf16x8& pa0, bf16x8& pa1, bf16x8& pa2, bf16x8& pa3) {
#pragma unroll
    for (int r = 0; r < 16; ++r) p1[r] = __builtin_amdgcn_exp2f(p1[r]);
    float ps = 0;
#pragma unroll
    for (int r = 0; r < 16; ++r) ps += p0[r];
#pragma unroll
    for (int r = 0; r < 16; ++r) ps += p1[r];
    { auto rr = __builtin_amdgcn_permlane32_swap(__float_as_uint(ps), __float_as_uint(ps), false, false);
      ps = __uint_as_float(rr[0]) + __uint_as_float(rr[1]); }
    l_reg = l_reg * alpha + ps;
#define PK4(P, BASE, OUT) do { unsigned a0 = cvt_pk_bf16(P[BASE + 0], P[BASE + 1]), a1 = cvt_pk_bf16(P[BASE + 2], P[BASE + 3]);   \
    unsigned b0 = cvt_pk_bf16(P[BASE + 4], P[BASE + 5]), b1 = cvt_pk_bf16(P[BASE + 6], P[BASE + 7]);                              \
    auto r0 = __builtin_amdgcn_permlane32_swap(a0, b0, false, false); auto r1 = __builtin_amdgcn_permlane32_swap(a1, b1, false, false); \
    u32x4 w = {r0[0], r1[0], r0[1], r1[1]}; OUT = *reinterpret_cast<bf16x8*>(&w); } while (0)
    PK4(p0, 0, pa0); PK4(p0, 8, pa1); PK4(p1, 0, pa2); PK4(p1, 8, pa3);
#undef PK4
}
__device__ __forceinline__ void qkt(f32x16& p0, f32x16& p1, const char* Ks, const bf16x8* qr, int r32, int hi, int cbase) {
    p0 = f32x16{}; p1 = f32x16{};
#pragma unroll
    for (int d0 = 0; d0 < 4; ++d0) { const int cb = cbase + (d0 * 16 + hi * 8) * 2;
        const bf16x8 b0 = *reinterpret_cast<const bf16x8*>(Ks + KSWZ(r32, cb));
        const bf16x8 b1 = *reinterpret_cast<const bf16x8*>(Ks + KSWZ(32 + r32, cb));
        p0 = __builtin_amdgcn_mfma_f32_32x32x16_bf16(b0, qr[d0], p0, 0, 0, 0);
        p1 = __builtin_amdgcn_mfma_f32_32x32x16_bf16(b1, qr[d0], p1, 0, 0, 0); }
}
__device__ __forceinline__ int v_st(int k, int c) { const int kk = (k & ~0xC) | ((k & 4) << 1) | ((k & 8) >> 1); return ((kk >> 3) * 4 + (c >> 5)) * 512 + ((kk & 7) * 32 + (c & 31)) * 2; }
__device__ __forceinline__ int v_rd_base(int lane) { return ((lane & 3) << 3) | (((lane >> 2) & 3) << 6) | (((lane >> 4) & 1) << 5) | (((lane >> 5) & 1) << 8); }
constexpr int v_rd_off(int d0, int ks, int half) { return d0 * 512 + ks * 4096 + half * 2048; }
template <int OFF> __device__ __forceinline__ s16x4 tr_read(int vb) {
    s16x4 r; asm volatile("ds_read_b64_tr_b16 %0, %1 offset:%2" : "=&v"(r) : "v"(vb), "i"(OFF) : "memory"); return r;
}
template <int D0> __device__ __forceinline__ void pv_one(f32x16& od, int vb, bf16x8 pa0, bf16x8 pa1, bf16x8 pa2, bf16x8 pa3) {
    const s16x4 l0 = tr_read<v_rd_off(D0, 0, 0)>(vb), h0 = tr_read<v_rd_off(D0, 0, 1)>(vb), l1 = tr_read<v_rd_off(D0, 1, 0)>(vb), h1 = tr_read<v_rd_off(D0, 1, 1)>(vb);
    const s16x4 l2 = tr_read<v_rd_off(D0, 2, 0)>(vb), h2 = tr_read<v_rd_off(D0, 2, 1)>(vb), l3 = tr_read<v_rd_off(D0, 3, 0)>(vb), h3 = tr_read<v_rd_off(D0, 3, 1)>(vb);
    asm volatile("s_waitcnt lgkmcnt(0)" ::: "memory"); SBAR();
#define PK(L, H) (bf16x8){L[0], L[1], L[2], L[3], H[0], H[1], H[2], H[3]}
    od = __builtin_amdgcn_mfma_f32_32x32x16_bf16(pa0, PK(l0, h0), od, 0, 0, 0);
    od = __builtin_amdgcn_mfma_f32_32x32x16_bf16(pa1, PK(l1, h1), od, 0, 0, 0);
    od = __builtin_amdgcn_mfma_f32_32x32x16_bf16(pa2, PK(l2, h2), od, 0, 0, 0);
    od = __builtin_amdgcn_mfma_f32_32x32x16_bf16(pa3, PK(l3, h3), od, 0, 0, 0);
#undef PK
}
__device__ __forceinline__ void pv_d0(f32x16* o, int vb, bf16x8 pa0, bf16x8 pa1, bf16x8 pa2, bf16x8 pa3) {
    pv_one<0>(o[0], vb, pa0, pa1, pa2, pa3); pv_one<1>(o[1], vb, pa0, pa1, pa2, pa3); pv_one<2>(o[2], vb, pa0, pa1, pa2, pa3); pv_one<3>(o[3], vb, pa0, pa1, pa2, pa3);
}

__device__ __forceinline__ void attn_unit(const bf16_t* __restrict__ P, bf16_t* __restrict__ Y, int qrow0, int krow0, int nkeys, int h, float lam, float osc, const float* __restrict__ subln_g, char* lds) {
    const int tid = opaque_tid(), wid = tid >> 6, lane = tid & 63, r32 = lane & 31, hi = lane >> 5, rg = wid & 3, comp = wid >> 2;
    char* V_lds = lds + OFF_V; char* K_lds = lds + OFF_K;
    float* ws = (float*)(lds + OFF_WS) + wid * 64; float* li_l = ws; float* al_l = ws + 32;
    float m_reg = -1e30f, l_reg = 0; f32x16 o[4] = {}; bf16x8 qr[4];
    const bf16_t* Qw = P + (size_t)(qrow0 + rg * 32 + r32) * N_IN + C_Q + h * 128 + comp * 64 + hi * 8;
#pragma unroll
    for (int d0 = 0; d0 < 4; ++d0) qr[d0] = *reinterpret_cast<const bf16x8*>(Qw + d0 * 16);
    const bf16_t* Kh = P + (size_t)krow0 * N_IN + C_K + h * 128; const bf16_t* Vh = P + (size_t)krow0 * N_IN + C_V + h * 128;
    const int sr = tid >> 4, sc = (tid & 15) * 8, vst0 = v_st(sr, sc), vst1 = v_st(32 + sr, sc);
    const int vb0 = (int)(uintptr_t)V_lds + v_rd_base(lane);
    const int cbase = comp * 128;
    struct { bf16x8 vs0, vs1, ks0, ks1; } sr_[2];
#define SLOAD(i, k0) do { sr_[i].vs0 = *reinterpret_cast<const bf16x8*>(&Vh[(size_t)((k0) + sr) * N_IN + sc]); sr_[i].vs1 = *reinterpret_cast<const bf16x8*>(&Vh[(size_t)((k0) + 32 + sr) * N_IN + sc]); \
    sr_[i].ks0 = *reinterpret_cast<const bf16x8*>(&Kh[(size_t)((k0) + sr) * N_IN + sc]); sr_[i].ks1 = *reinterpret_cast<const bf16x8*>(&Kh[(size_t)((k0) + 32 + sr) * N_IN + sc]); } while (0)
#define SWRITE(b, i) do { *(bf16x8*)(V_lds + (b) * SHM_V + vst0) = sr_[i].vs0; *(bf16x8*)(V_lds + (b) * SHM_V + vst1) = sr_[i].vs1; const int kc = sc * 2; \
    *(bf16x8*)(K_lds + (b) * SHM_K + KSWZ(sr, kc)) = sr_[i].ks0; *(bf16x8*)(K_lds + (b) * SHM_K + KSWZ(32 + sr, kc)) = sr_[i].ks1; } while (0)
#define SWAIT() asm volatile("s_waitcnt vmcnt(4)" ::: "memory")
#define RESC(a) do { if (__any((a) < 1.f)) { if (hi == 0) al_l[r32] = (a); asm volatile("s_waitcnt lgkmcnt(0)" ::: "memory"); \
    _Pragma("unroll") for (int d = 0; d < 4; ++d) _Pragma("unroll") for (int r = 0; r < 16; ++r) o[d][r] *= al_l[crow(r, hi)]; } } while (0)
    f32x16 pA0, pA1, pB0, pB1; float mnA, mnB, alA, alB; bf16x8 pa0, pa1, pa2, pa3; const int NT = nkeys / KVBLK;
    constexpr int SE = 0, SO = 1;
    SLOAD(SE, 0); asm volatile("s_waitcnt vmcnt(0)" ::: "memory"); SWRITE(0, SE); __syncthreads();
    qkt(pA0, pA1, K_lds, qr, r32, hi, cbase); partialSM(pA0, pA1, m_reg, mnA, alA);
    SLOAD(SO, KVBLK); if (2 < NT) SLOAD(SE, 2 * KVBLK);
    SWAIT(); SWRITE(1, SO); __syncthreads();
    for (int j = 1; j + 1 < NT; j += 2) {
        SBAR(); qkt(pB0, pB1, K_lds + SHM_K, qr, r32, hi, cbase);
        finishSM(pA0, pA1, alA, l_reg, pa0, pa1, pa2, pa3); SBAR();
        SLOAD(SO, (j + 2) * KVBLK); SBAR();
        pv_d0(o, vb0, pa0, pa1, pa2, pa3); partialSM(pB0, pB1, m_reg, mnB, alB);
        __syncthreads(); SWAIT(); SWRITE(0, SE);
        RESC(alB); __syncthreads();
        SBAR(); qkt(pA0, pA1, K_lds, qr, r32, hi, cbase);
        finishSM(pB0, pB1, alB, l_reg, pa0, pa1, pa2, pa3); SBAR();
        if (j + 3 < NT) SLOAD(SE, (j + 3) * KVBLK); SBAR();
        pv_d0(o, vb0 + SHM_V, pa0, pa1, pa2, pa3); partialSM(pA0, pA1, m_reg, mnA, alA);
        __syncthreads(); SWAIT(); SWRITE(1, SO);
        RESC(alA); __syncthreads();
    }
    SBAR(); qkt(pB0, pB1, K_lds + SHM_K, qr, r32, hi, cbase);
    finishSM(pA0, pA1, alA, l_reg, pa0, pa1, pa2, pa3); SBAR();
    pv_d0(o, vb0, pa0, pa1, pa2, pa3); partialSM(pB0, pB1, m_reg, mnB, alB);
    __syncthreads(); RESC(alB);
    finishSM(pB0, pB1, alB, l_reg, pa0, pa1, pa2, pa3); SBAR();
    pv_d0(o, vb0 + SHM_V, pa0, pa1, pa2, pa3);
    if (hi == 0) li_l[r32] = l_reg; asm volatile("s_waitcnt lgkmcnt(0)" ::: "memory");
#pragma unroll
    for (int r = 0; r < 16; ++r) { const float rl = __builtin_amdgcn_rcpf(li_l[crow(r, hi)]);
#pragma unroll
        for (int d0 = 0; d0 < 4; ++d0) o[d0][r] *= rl; }
    __syncthreads();
    float* X = (float*)lds + (size_t)rg * 64 * 64 + lane;
    if (comp == 1) {
#pragma unroll
        for (int d0 = 0; d0 < 4; ++d0)
#pragma unroll
            for (int r = 0; r < 16; ++r) X[(d0 * 16 + r) * 64] = o[d0][r];
    }
    __syncthreads();
    if (comp == 0) {
        float rs[16];
#pragma unroll
        for (int r = 0; r < 16; ++r) { float ss = 0.f;
#pragma unroll
            for (int d0 = 0; d0 < 4; ++d0) { o[d0][r] -= lam * X[(d0 * 16 + r) * 64]; ss += o[d0][r] * o[d0][r]; }
#pragma unroll
            for (int x = 1; x < 32; x <<= 1) ss += __shfl_xor(ss, x);
            rs[r] = rsqrtf(ss * (1.f / 128.f) + EPS) * osc; }
#pragma unroll
        for (int d0 = 0; d0 < 4; ++d0) { const int col = d0 * 32 + r32; const float sg = subln_g[col];
#pragma unroll
            for (int r = 0; r < 16; ++r) { const size_t row = (size_t)(qrow0 + rg * 32 + crow(r, hi));
                const float g = bf2f(P[row * N_IN + C_GA + h * 128 + col]);
                Y[row * DM + h * 128 + col] = (bf16_t)f2bf(o[d0][r] * rs[r] * sg * silu_f(g)); } }
    }
    __syncthreads();
#undef SLOAD
#undef SWRITE
#undef SWAIT
#undef RESC
}
#undef KSWZ
#undef SBAR
}

namespace mixu {
constexpr int TT = 32;
constexpr int OFF_YS = 0;
constexpr int AB_STRIDE = 1040;
constexpr int OFF_AB = 65536;
struct Args { const bf16_t* P; bf16_t* Y; const bf16_t* wpool_t; const float* pool_scale; const float* w_dw; const float* b_dw; const float* ln_g; const float* ln_b; const bf16_t* wpw2_t; };

template <int HW> __device__ __forceinline__ void pool_diff(const bf16_t* __restrict__ up, int tl0, int L, LAS unsigned char* ab, int c) {
    float u[TT + 2 * HW];
#pragma unroll
    for (int p = 0; p < TT + 2 * HW; ++p) { const int tl = tl0 - HW + p; u[p] = (tl >= 0 && tl < L) ? bf2f(up[(size_t)tl * N_IN]) : 0.f; }
    float s = 0.f;
#pragma unroll
    for (int p = 0; p < 2 * HW; ++p) s += u[p];
#pragma unroll
    for (int tk = 0; tk < TT; ++tk) { const int tl = tl0 + tk; const int lo = max(tl - HW, 0), hi = min(tl + HW, L);
        const float d = s / (float)(hi - lo) - u[tk + HW];
        *(LAS bf16_t*)(ab + tk * AB_STRIDE + c * 2) = (bf16_t)f2bf(d);
        if (tk + 1 < TT) s += u[tk + 2 * HW] - u[tk]; }
}

__device__ __forceinline__ void mix_unit(const Args& a, int row0, LAS unsigned char* lds) {
    const int tid = opaque_tid(), wid = __builtin_amdgcn_readfirstlane(tid >> 6), lane = tid & 63, fr = lane & 15, fq = lane >> 4;
    const int b = row0 / TPB, t0 = row0 % TPB; const bool isctx = t0 < CTX;
    const int seq0 = b * TPB + (isctx ? 0 : CTX), L = isctx ? CTX : SEQ, tl0 = isctx ? t0 : t0 - CTX;
    LAS unsigned char* ab = lds + OFF_AB; LAS float* ys = (LAS float*)(lds + OFF_YS);
    const bf16_t* P = a.P;
    { const int c = tid; const bf16_t* up = P + (size_t)seq0 * N_IN + C_UP + c;
      switch (wid >> 1) { case 0: pool_diff<1>(up, tl0, L, ab, c); break; case 1: pool_diff<2>(up, tl0, L, ab, c); break; case 2: pool_diff<4>(up, tl0, L, ab, c); break; default: pool_diff<8>(up, tl0, L, ab, c); break; } }
    __syncthreads();
    {
      const int g = wid >> 1, nh = wid & 1;
      f32x4 acc[2][4];
#pragma unroll
      for (int m = 0; m < 2; ++m)
#pragma unroll
          for (int nb = 0; nb < 4; ++nb) acc[m][nb] = (f32x4){0.f, 0.f, 0.f, 0.f};
      const bf16_t* wt = a.wpool_t + (size_t)g * 128 * 128 + (size_t)(nh * 64 + fr) * 128 + fq * 8;
#pragma unroll
      for (int ks = 0; ks < 4; ++ks) { bf16x8 af[2], bfr[4];
#pragma unroll
          for (int m = 0; m < 2; ++m) af[m] = *(const LAS bf16x8*)(ab + (m * 16 + fr) * AB_STRIDE + (g * 128 + ks * 32 + fq * 8) * 2);
#pragma unroll
          for (int nb = 0; nb < 4; ++nb) bfr[nb] = *(const bf16x8*)(wt + (size_t)nb * 16 * 128 + ks * 32);
#pragma unroll
          for (int m = 0; m < 2; ++m)
#pragma unroll
              for (int nb = 0; nb < 4; ++nb) acc[m][nb] = __builtin_amdgcn_mfma_f32_16x16x32_bf16(bfr[nb], af[m], acc[m][nb], 0, 0, 0); }
#pragma unroll
      for (int nb = 0; nb < 4; ++nb) { const int n = g * 128 + nh * 64 + nb * 16 + fq * 4; const f32x4 ps = *(const f32x4*)(a.pool_scale + n);
#pragma unroll
          for (int m = 0; m < 2; ++m) { const size_t row = (size_t)row0 + m * 16 + fr;
              const u32x2 gw = *(const u32x2*)(P + row * N_IN + C_GP + n);
              const float g0 = __uint_as_float(gw.x << 16), g1 = __uint_as_float(gw.x & 0xffff0000u), g2 = __uint_as_float(gw.y << 16), g3 = __uint_as_float(gw.y & 0xffff0000u);
              const f32x4 v = acc[m][nb] * ps;
              u32x2 w; w.x = pk2(v[0] * silu_f(g0), v[1] * silu_f(g1)); w.y = pk2(v[2] * silu_f(g2), v[3] * silu_f(g3));
              *(u32x2*)(a.Y + row * DM + 1024 + n) = w; } }
    }
    { const int c = tid; float y[TT], w[31];
#pragma unroll
      for (int j = 0; j < 31; ++j) w[j] = a.w_dw[j * 512 + c];
      const float bias = a.b_dw[c];
#pragma unroll
      for (int tk = 0; tk < TT; ++tk) y[tk] = bias;
      const bf16_t* cp = P + (size_t)seq0 * N_IN + C_CA + c;
#pragma unroll
      for (int p = 0; p < TT + 30; ++p) { const int tl = tl0 - 15 + p; float u = 0.f;
          if (tl >= 0 && tl < L) { const float av = bf2f(cp[(size_t)tl * N_IN]), bv = bf2f(cp[(size_t)tl * N_IN + 512]); u = av * sigm_f(bv); }
#pragma unroll
          for (int tk = 0; tk < TT; ++tk) { const int j = p - tk; if (j >= 0 && j < 31) y[tk] += u * w[j]; } }
#pragma unroll
      for (int tk = 0; tk < TT; ++tk) ys[tk * 512 + c] = y[tk]; }
    __syncthreads();
#pragma unroll
    for (int q = 0; q < 4; ++q) { const int tk = wid * 4 + q; float v[8], s = 0.f;
#pragma unroll
        for (int j = 0; j < 8; ++j) { v[j] = ys[tk * 512 + lane + 64 * j]; s += v[j]; }
        const float mu = wave_sum(s) * (1.f / 512.f); float qq = 0.f;
#pragma unroll
        for (int j = 0; j < 8; ++j) { v[j] -= mu; qq += v[j] * v[j]; }
        const float rs = rsqrtf(wave_sum(qq) * (1.f / 512.f) + EPS);
#pragma unroll
        for (int j = 0; j < 8; ++j) { const int c = lane + 64 * j; const float z = v[j] * rs * a.ln_g[c] + a.ln_b[c];
            *(LAS bf16_t*)(ab + tk * AB_STRIDE + c * 2) = (bf16_t)f2bf(silu_f(z)); } }
    __syncthreads();
    {
      f32x4 acc[2][4];
#pragma unroll
      for (int m = 0; m < 2; ++m)
#pragma unroll
          for (int nb = 0; nb < 4; ++nb) acc[m][nb] = (f32x4){0.f, 0.f, 0.f, 0.f};
      const bf16_t* wt = a.wpw2_t + (size_t)(wid * 64 + fr) * 512 + fq * 8;
#pragma unroll 2
      for (int ks = 0; ks < 16; ++ks) { bf16x8 af[2], bfr[4];
#pragma unroll
          for (int m = 0; m < 2; ++m) af[m] = *(const LAS bf16x8*)(ab + (m * 16 + fr) * AB_STRIDE + (ks * 32 + fq * 8) * 2);
#pragma unroll
          for (int nb = 0; nb < 4; ++nb) bfr[nb] = *(const bf16x8*)(wt + (size_t)nb * 16 * 512 + ks * 32);
#pragma unroll
          for (int m = 0; m < 2; ++m)
#pragma unroll
              for (int nb = 0; nb < 4; ++nb) acc[m][nb] = __builtin_amdgcn_mfma_f32_16x16x32_bf16(bfr[nb], af[m], acc[m][nb], 0, 0, 0); }
#pragma unroll
      for (int nb = 0; nb < 4; ++nb) { const int n = wid * 64 + nb * 16 + fq * 4;
#pragma unroll
          for (int m = 0; m < 2; ++m) { const size_t row = (size_t)row0 + m * 16 + fr;
              const u32x2 gw = *(const u32x2*)(P + row * N_IN + C_GC + n);
              const float g0 = __uint_as_float(gw.x << 16), g1 = __uint_as_float(gw.x & 0xffff0000u), g2 = __uint_as_float(gw.y << 16), g3 = __uint_as_float(gw.y & 0xffff0000u);
              const f32x4 v = acc[m][nb];
              u32x2 w; w.x = pk2(v[0] * silu_f(g0), v[1] * silu_f(g1)); w.y = pk2(v[2] * silu_f(g2), v[3] * silu_f(g3));
              *(u32x2*)(a.Y + row * DM + 1536 + n) = w; } }
    }
    __syncthreads();
}
}

#define XB_TMO      128
#define XB_XCNT(j)  (256  + 64 * (j))
#define XB_XSUB(j)  (1280 + 64 * (j))
#define XB_XGEN(j)  (2304 + 64 * (j))
#define XB_TOP      3328
#define XB_TOPGEN   3392
#define XCD_BAR_WORDS 3456
#define XB_SPIN_CAP (1u << 18)
__device__ __forceinline__ unsigned xb_ld(unsigned* p)              { return __hip_atomic_load(p, __ATOMIC_RELAXED, __HIP_MEMORY_SCOPE_AGENT); }
__device__ __forceinline__ unsigned xb_add(unsigned* p, unsigned v) { return __hip_atomic_fetch_add(p, v, __ATOMIC_RELAXED, __HIP_MEMORY_SCOPE_AGENT); }
__device__ __forceinline__ unsigned xb_xcc_id() { return (unsigned)__builtin_amdgcn_s_getreg((3 << 11) | 20) & 0xFu; }
#define XB_SPIN(cond, bar) do { unsigned _sp = 0; while (cond) { __builtin_amdgcn_s_sleep(1); \
    if ((++_sp & 255u) == 0u) { if (xb_ld(&(bar)[XB_TMO])) break; if (_sp > XB_SPIN_CAP) { atomicAdd(&(bar)[XB_TMO], 1u); break; } } } } while (0)
struct XcdBarrier { unsigned* bar; unsigned x; volatile LAS unsigned* st; };
__device__ __forceinline__ XcdBarrier xcd_barrier_post(unsigned* bar, volatile LAS unsigned* st) {
    XcdBarrier b; b.bar = bar; b.x = xb_xcc_id(); b.st = st;
    if (threadIdx.x == 0) (void)xb_add(&bar[XB_XCNT(b.x)], 1u);
    return b;
}
__device__ __forceinline__ void xcd_barrier_complete(unsigned* bar, unsigned x, unsigned& nloc, unsigned& nx) {
    const unsigned G = gridDim.x * gridDim.y * gridDim.z;
    unsigned sum, cnt, mine, sp = 0u;
    for (;;) {
        sum = 0u; cnt = 0u; mine = 0u;
#pragma unroll
        for (unsigned j = 0; j < 16; ++j) { const unsigned c = xb_ld(&bar[XB_XCNT(j)]); sum += c; cnt += (c > 0u) ? 1u : 0u; mine = (j == x) ? c : mine; }
        if (sum == G) break;
        __builtin_amdgcn_s_sleep(1);
        if ((++sp & 255u) == 0u) { if (xb_ld(&bar[XB_TMO])) break; if (sp > XB_SPIN_CAP) { atomicAdd(&bar[XB_TMO], 1u); break; } }
    }
    nloc = mine > 0u ? mine : 1u; nx = cnt > 0u ? cnt : 1u;
}
__device__ __forceinline__ void xcd_barrier(const XcdBarrier& b) {
    asm volatile("s_waitcnt vmcnt(0)" ::: "memory");
    __syncthreads();
    if (threadIdx.x == 0) {
        unsigned* bar = b.bar;
        __builtin_amdgcn_s_waitcnt(0);
        unsigned nloc = b.st[0], nx = b.st[1];
        if (nloc == 0u) { xcd_barrier_complete(bar, b.x, nloc, nx); b.st[0] = nloc; b.st[1] = nx; }
        const unsigned old = xb_add(&bar[XB_XSUB(b.x)], 1u);
        const unsigned gen = old / nloc;
        if (old + 1u == (gen + 1u) * nloc) {
            __builtin_amdgcn_fence(__ATOMIC_RELEASE, "agent");
            asm volatile("s_waitcnt vmcnt(0)" ::: "memory");
            const unsigned og = xb_add(&bar[XB_TOP], 1u);
            const unsigned tg = og / nx;
            if (og + 1u == (tg + 1u) * nx) xb_add(&bar[XB_TOPGEN], 1u);
            else XB_SPIN(xb_ld(&bar[XB_TOPGEN]) == tg, bar);
            __builtin_amdgcn_fence(__ATOMIC_ACQUIRE, "agent");
            xb_add(&bar[XB_XGEN(b.x)], 1u);
            asm volatile("s_waitcnt vmcnt(0)" ::: "memory");
        } else {
            XB_SPIN(xb_ld(&bar[XB_XGEN(b.x)]) == gen, bar);
            __builtin_amdgcn_fence(__ATOMIC_ACQUIRE, "agent");
            asm volatile("s_waitcnt vmcnt(0)" ::: "memory");
        }
    }
    __syncthreads();
}

__device__ __forceinline__ void p0_transpose_item(const float* W, int K, int N, bf16_t* WT, LAS float* scr, int item, int lane) {
    const int nblk = N / 32, kb = item / nblk, nb = item % nblk, k0 = 64 * kb, n0 = 32 * nb;
#pragma unroll 8
    for (int i = 0; i < 32; ++i) { const int kk = 2 * i + (lane >> 5); scr[kk * 33 + (lane & 31)] = W[(size_t)(k0 + kk) * N + n0 + (lane & 31)]; }
    asm volatile("s_waitcnt lgkmcnt(0)" ::: "memory");
    const int c = lane & 7;
#pragma unroll
    for (int j = 0; j < 4; ++j) { const int n = (lane >> 3) + 8 * j; const LAS float* s = scr + (8 * c) * 33 + n;
        u32x4 o; o.x = pk2(s[0 * 33], s[1 * 33]); o.y = pk2(s[2 * 33], s[3 * 33]); o.z = pk2(s[4 * 33], s[5 * 33]); o.w = pk2(s[6 * 33], s[7 * 33]);
        *(u32x4*)(WT + (size_t)(n0 + n) * K + k0 + 8 * c) = o; }
    asm volatile("s_waitcnt lgkmcnt(0)" ::: "memory");
}

struct Args {
    const float* in[22]; float* out; unsigned char* ws; int ph_lo, ph_hi;
};

__device__ __forceinline__ void norm_row(const float* __restrict__ xsrc, const float* __restrict__ csrc, const float* __restrict__ g, const float* __restrict__ MODl, bf16_t* __restrict__ H, int row, int lane) {
    const int b = row / TPB, t = row % TPB; const bool isctx = t < CTX;
    const float* src = isctx ? csrc + ((size_t)b * CTX + t) * DM : xsrc + ((size_t)b * SEQ + (t - CTX)) * DM;
    const float* mod = MODl + (size_t)(isctx ? 4 : b) * N_MOD;
    f32x4 v[8]; float ss = 0.f;
#pragma unroll
    for (int j = 0; j < 8; ++j) { v[j] = ((const f32x4*)src)[lane + 64 * j]; ss += (v[j][0] * v[j][0] + v[j][1] * v[j][1]) + (v[j][2] * v[j][2] + v[j][3] * v[j][3]); }
    ss = wave_sum(ss);
    const float rstd = rsqrtf(ss * (1.f / DM) + EPS);
#pragma unroll
    for (int j = 0; j < 8; ++j) { const int col = (lane + 64 * j) * 4;
        const f32x4 gg = *(const f32x4*)(g + col), sh = *(const f32x4*)(mod + col), sc = *(const f32x4*)(mod + 2048 + col);
        const f32x4 o = v[j] * rstd * gg * (sc + 1.f) + sh;
        u32x2 w; w.x = pk2(o[0], o[1]); w.y = pk2(o[2], o[3]);
        *(u32x2*)(H + (size_t)row * DM + col) = w; }
}

__global__ void __launch_bounds__(NTHREADS, 2) mega_fwd(Args args) {
    extern __shared__ __attribute__((aligned(16))) unsigned char lds_raw[];
    LAS unsigned char* lds = (LAS unsigned char*)lds_raw;
    const int G = gridDim.x, bx = blockIdx.x; const int vcu = (G % 8 == 0) ? (bx % 8) * (G / 8) + bx / 8 : bx;
    unsigned char* ws = args.ws;
    unsigned* ctl = (unsigned*)(ws + WS_CTL);
    const float* x = args.in[0]; const float* c_in = args.in[1]; const float* ctx = args.in[2]; const float* c_ctx = args.in[3];
    const float* w_mod = args.in[4]; const float* b_mod = args.in[5]; const float* norm_g = args.in[6]; const float* w_in = args.in[7];
    const float* subln_g = args.in[12]; const float* w_pool = args.in[13]; const float* pool_scale = args.in[14]; const float* w_dw = args.in[15];
    const float* b_dw = args.in[16]; const float* ln_g = args.in[17]; const float* ln_b = args.in[18]; const float* w_pw2 = args.in[19];
    const float* w_out = args.in[20]; const float* final_g = args.in[21];
    float* out = args.out;
    float* ROPE = (float*)(ws + WS_ROPE); float* MOD = (float*)(ws + WS_MOD);
    bf16_t* WIN = (bf16_t*)(ws + WS_WIN); bf16_t* WOUT = (bf16_t*)(ws + WS_WOUT); bf16_t* WPW2 = (bf16_t*)(ws + WS_WPW2); bf16_t* WPOOL = (bf16_t*)(ws + WS_WPOOL);
    float* CTXRES = (float*)(ws + WS_CTXRES); bf16_t* H = (bf16_t*)(ws + WS_H); bf16_t* P = (bf16_t*)(ws + WS_P); bf16_t* Y = (bf16_t*)(ws + WS_YMIX);

#if MK_USE_CG
    cg::grid_group grid = cg::this_grid();
#define SEAM() do { __syncthreads(); grid.sync(); } while (0)
#else
    if (args.ph_lo < 0) cg::this_grid().sync();
    for (int u = threadIdx.x; u < (LDS_BYTES - LDSCTL_OFF) / 4; u += NTHREADS) ((LAS unsigned*)(lds + LDSCTL_OFF))[u] = 0u;
    __syncthreads();
    XcdBarrier bar = xcd_barrier_post(ctl + CW_BAR, (volatile LAS unsigned*)(lds + MISC_OFF) + 8);
#define SEAM() xcd_barrier(bar)
#endif
    const int lo = args.ph_lo, hi = args.ph_hi;
#define IN(k) (lo <= (k) && (k) < hi)
#define BOTH(k) (IN(k) && IN((k) + 1))
    const int NGW = G * NWAVES;
#define PHASE_IDS() const int tid = opaque_tid(), lane = tid & 63, wave = __builtin_amdgcn_readfirstlane(tid >> 6), gw = vcu * NWAVES + wave; (void)gw; (void)lane

    if (IN(0)) {
        PHASE_IDS();
        constexpr int N_MODITEMS = 2 * (N_MOD / 64);
        constexpr int I_WIN = (DM / 64) * (N_IN / 32), I_WOUT = (DM / 64) * (DM / 32), I_PW2 = (512 / 64) * (512 / 32), I_POOL = (128 / 64) * (128 / 32);
        constexpr int N_TR = 2 * I_WIN + 2 * I_WOUT + 2 * I_PW2 + 8 * I_POOL;
        constexpr int N_BITEMS = N_MODITEMS + 1 + (N_TR + 7) / 8;
        for (int it = bx; it < N_BITEMS; it += G) {
            if (it < N_MODITEMS) {
                const int l = it / (N_MOD / 64), cgp = it % (N_MOD / 64);
                LAS float* s = (LAS float*)lds; LAS float* red = (LAS float*)(lds + 5 * 2048 * 4);
                for (int i = tid; i < 5 * 2048; i += NTHREADS) { const int r = i >> 11, k = i & 2047; const float v = r < 4 ? c_in[r * 2048 + k] : c_ctx[k]; s[i] = v / (1.f + expf(-v)); }
                __syncthreads();
                float acc[5] = {0.f, 0.f, 0.f, 0.f, 0.f};
                const float* W = w_mod + (size_t)l * DM * N_MOD + cgp * 64 + lane;
#pragma unroll 8
                for (int k = wave * 256; k < wave * 256 + 256; ++k) { const float w = W[(size_t)k * N_MOD];
#pragma unroll
                    for (int r = 0; r < 5; ++r) acc[r] += s[r * 2048 + k] * w; }
#pragma unroll
                for (int r = 0; r < 5; ++r) red[(wave * 5 + r) * 64 + lane] = acc[r];
                __syncthreads();
                if (tid < 320) { const int r = tid >> 6, ln = tid & 63; float v = b_mod[l * N_MOD + cgp * 64 + ln];
#pragma unroll
                    for (int w8 = 0; w8 < 8; ++w8) v += red[(w8 * 5 + r) * 64 + ln];
                    MOD[((size_t)l * 5 + r) * N_MOD + cgp * 64 + ln] = v; }
                __syncthreads();
            } else if (it == N_MODITEMS) {
                for (int i = tid; i < 64 * 16; i += NTHREADS) { const int pos = i >> 4, fi = i & 15; const float inv = powf(10000.f, -(float)fi / 16.f), ang = (float)pos * inv;
                    ROPE[i * 2] = cosf(ang); ROPE[i * 2 + 1] = sinf(ang); }
                if (tid < 2) { const int l = tid; float a = 0.f, b = 0.f;
                    for (int i = 0; i < 64; ++i) { a += args.in[8][l * 64 + i] * args.in[9][l * 64 + i]; b += args.in[10][l * 64 + i] * args.in[11][l * 64 + i]; }
                    const float lam_init = 0.8f - 0.6f * expf(-0.3f * (float)l);
                    MOD[2 * 5 * N_MOD + l] = expf(a) - expf(b) + lam_init; }
            } else {
                LAS float* scr = (LAS float*)(lds + wave * 16384);
                int r = (it - N_MODITEMS - 1) * 8 + wave;
                if (r < N_TR) {
                    if (r < 2 * I_WIN) { const int l = r / I_WIN; p0_transpose_item(w_in + (size_t)l * DM * N_IN, DM, N_IN, WIN + (size_t)l * DM * N_IN, scr, r % I_WIN, lane); }
                    else if ((r -= 2 * I_WIN) < 2 * I_WOUT) { const int l = r / I_WOUT; p0_transpose_item(w_out + (size_t)l * DM * DM, DM, DM, WOUT + (size_t)l * DM * DM, scr, r % I_WOUT, lane); }
                    else if ((r -= 2 * I_WOUT) < 2 * I_PW2) { const int l = r / I_PW2; p0_transpose_item(w_pw2 + (size_t)l * 512 * 512, 512, 512, WPW2 + (size_t)l * 512 * 512, scr, r % I_PW2, lane); }
                    else { r -= 2 * I_PW2; const int lg = r / I_POOL; p0_transpose_item(w_pool + (size_t)lg * 128 * 128, 128, 128, WPOOL + (size_t)lg * 128 * 128, scr, r % I_POOL, lane); }
                }
            }
        }
        if (BOTH(0)) SEAM();
    }

#pragma unroll 1
    for (int l = 0; l < DEPTH; ++l) {
        const float* MODl = MOD + (size_t)l * 5 * N_MOD;
        const float* xsrc = l == 0 ? x : out; const float* csrc = l == 0 ? ctx : CTXRES;
        const bool last = (l == DEPTH - 1);
        if (IN(1 + 4 * l)) {
            PHASE_IDS();
            for (int row = gw; row < M_TOT; row += NGW) norm_row(xsrc, csrc, norm_g + l * DM, MODl, H, row, lane);
            if (BOTH(1 + 4 * l)) SEAM();
        }
        if (IN(2 + 4 * l)) {
            pg8::Gemm g{H, WIN + (size_t)l * DM * N_IN, M_TOT, N_IN, DM};
            pg8::TileSched S; if (!last) S.init(36, N_IN / 256, 0, 0, G, bx); else S.init(32, N_IN / 256, 32, 1, G, bx);
            pg8::EpiIn E{P, ROPE};
            pg8::gemm_phase<pg8::EpiIn, pg8::TileSched, true, true>(lds, g, S, E);
            if (BOTH(2 + 4 * l)) SEAM();
        }
        if (IN(3 + 4 * l)) {
            const float lam = MOD[2 * 5 * N_MOD + l], lam_init = 0.8f - 0.6f * expf(-0.3f * (float)l), osc = 1.f - lam_init;
            { mixu::Args ma{P, Y, WPOOL + (size_t)l * 4 * 128 * 128, pool_scale + l * 512, w_dw + (size_t)l * 31 * 512, b_dw + l * 512, ln_g + l * 512, ln_b + l * 512, WPW2 + (size_t)l * 512 * 512};
              const int ntiles = last ? BATCH * SEQ / 32 : M_TOT / 32;
              for (int t = vcu; t < ntiles; t += G) { int row0;
                  if (last) row0 = (t / 64) * TPB + CTX + (t % 64) * 32; else row0 = t * 32;
                  mixu::mix_unit(ma, row0, lds); } }
            { constexpr int NUL = BATCH * HEADS * (SEQ / 128), NUC = BATCH * HEADS * (CTX / 128); const int upc = (NUL + G - 1) / G, ncx = last ? 0 : (NUC + G - 1) / G;
              for (int i = 0; i < upc + ncx; ++i) {
                  int qrow0, krow0, nkeys, h;
                  if (i < upc) { const int id = vcu * upc + i; if (id >= NUL) continue;
                      const int bh = id / (SEQ / 128), qb = id % (SEQ / 128), b = bh / HEADS; h = bh % HEADS; qrow0 = b * TPB + CTX + qb * 128; krow0 = b * TPB; nkeys = TPB; }
                  else { const int id = vcu + (i - upc) * G; if (id >= NUC) continue;
                      const int bh = id / (CTX / 128), qb = id % (CTX / 128), b = bh / HEADS; h = bh % HEADS; qrow0 = b * TPB + qb * 128; krow0 = b * TPB; nkeys = CTX; }
                  att::attn_unit(P, Y, qrow0, krow0, nkeys, h, lam, osc, subln_g + l * 128, (char*)lds_raw); } }
            if (BOTH(3 + 4 * l)) SEAM();
        }
        if (IN(4 + 4 * l)) {
            pg8::Gemm g{Y, WOUT + (size_t)l * DM * DM, M_TOT, DM, DM};
            pg8::TileSched S; if (!last) S.init(36, DM / 256, 0, 0, G, bx); else S.init(32, DM / 256, 0, 1, G, bx);
            pg8::EpiOut E{xsrc, csrc, out, CTXRES, MODl};
            pg8::gemm_phase<pg8::EpiOut, pg8::TileSched, true, true>(lds, g, S, E);
            if (BOTH(4 + 4 * l)) SEAM();
        }
    }
    if (IN(9)) {
        PHASE_IDS();
        for (int row = gw; row < BATCH * SEQ; row += NGW) {
            f32x4* p = (f32x4*)(out + (size_t)row * DM); f32x4 v[8]; float ss = 0.f;
#pragma unroll
            for (int j = 0; j < 8; ++j) { v[j] = p[lane + 64 * j]; ss += (v[j][0] * v[j][0] + v[j][1] * v[j][1]) + (v[j][2] * v[j][2] + v[j][3] * v[j][3]); }
            const float rstd = rsqrtf(wave_sum(ss) * (1.f / DM) + EPS);
#pragma unroll
            for (int j = 0; j < 8; ++j) { const f32x4 gg = *(const f32x4*)(final_g + (lane + 64 * j) * 4); p[lane + 64 * j] = v[j] * rstd * gg; }
        }
    }
#undef IN
#undef BOTH
#undef SEAM
}

extern "C" void kernel_launch(void* const* d_in, const int* in_sizes, int n_in, void* d_out, int out_size, void* d_ws, size_t ws_size, hipStream_t stream) {
    static int grid = 0;
    if (grid == 0) {
        if (n_in != 22 || ws_size < WS_END || out_size != BATCH * SEQ * DM) { fprintf(stderr, "kernel_launch: unexpected n_in %d / out %d / ws %zu\n", n_in, out_size, ws_size); grid = -1; return; }
        int dev = 0, cus = 0, per_cu = 0;
        if (hipGetDevice(&dev) != hipSuccess || hipDeviceGetAttribute(&cus, hipDeviceAttributeMultiprocessorCount, dev) != hipSuccess) { grid = -1; return; }
        if (hipFuncSetAttribute((const void*)mega_fwd, hipFuncAttributeMaxDynamicSharedMemorySize, LDS_BYTES) != hipSuccess) { fprintf(stderr, "kernel_launch: hipFuncSetAttribute failed\n"); grid = -1; return; }
        if (hipOccupancyMaxActiveBlocksPerMultiprocessor(&per_cu, (const void*)mega_fwd, NTHREADS, LDS_BYTES) != hipSuccess || per_cu < 1) { fprintf(stderr, "kernel_launch: occupancy query says %d blocks per CU\n", per_cu); grid = -1; return; }
        (void)hipGetLastError();
        grid = cus;
    }
    if (grid < 0) return;
    (void)hipMemsetAsync((char*)d_ws + WS_CTL, 0, CTL_ZERO_BYTES, stream);
    Args a{};
    for (int i = 0; i < 22; ++i) a.in[i] = (const float*)d_in[i];
    a.out = (float*)d_out; a.ws = (unsigned char*)d_ws;
#if MK_PER_PHASE
    for (int ph = 0; ph < 10; ++ph) { a.ph_lo = ph; a.ph_hi = ph + 1;
        void* kargs[] = {&a};
        hipError_t e = hipLaunchCooperativeKernel((void*)mega_fwd, dim3(grid), dim3(NTHREADS), kargs, LDS_BYTES, stream);
        if (e != hipSuccess) { fprintf(stderr, "kernel_launch: launch failed: %s\n", hipGetErrorString(e)); break; } }
#else
    a.ph_lo = 0; a.ph_hi = 10;
    void* kargs[] = {&a};
    hipError_t e = hipLaunchCooperativeKernel((void*)mega_fwd, dim3(grid), dim3(NTHREADS), kargs, LDS_BYTES, stream);
    if (e != hipSuccess) fprintf(stderr, "kernel_launch: cooperative launch failed: %s (grid %d)\n", hipGetErrorString(e), grid);
#endif
}
```

```cpp
#include <hip/hip_runtime.h>
#include <hip/hip_cooperative_groups.h>
#include <cstdint>
#include <cstdio>
#include <cmath>
namespace cg = cooperative_groups;

#ifndef MK_USE_CG
#define MK_USE_CG 0
#endif
#ifndef REP_P0
#define REP_P0 1
#endif
#ifndef REP_NORM
#define REP_NORM 1
#endif
#ifndef REP_INPROJ
#define REP_INPROJ 1
#endif
#ifndef REP_MIX
#define REP_MIX 1
#endif
#ifndef REP_ATT
#define REP_ATT 1
#endif
#ifndef REP_OUT
#define REP_OUT 1
#endif
#ifndef REP_MX_POOL
#define REP_MX_POOL 1
#endif
#ifndef REP_MX_GLU
#define REP_MX_GLU 1
#endif
#ifndef REP_MX_CONV
#define REP_MX_CONV 1
#endif
#ifndef REP_MX_LN
#define REP_MX_LN 1
#endif
#ifndef REP_MX_PW2
#define REP_MX_PW2 1
#endif
#ifndef MK_PROBE
#define MK_PROBE 0
#endif
#define PROBE_X0 14
#define PROBE_X1 15
#define PROBE_Y0 15
#define PROBE_Y1 16
#define PROBE_AMP 8
#if MK_PROBE
#define STAMP(k) do { if (blockIdx.x == 0 && threadIdx.x == 0) { g_ts[(k)] = __builtin_amdgcn_s_memrealtime(); } } while (0)
#else
#define STAMP(k) do { } while (0)
#endif
#ifndef MK_COOP
#define MK_COOP 0
#endif
#ifndef MK_PER_PHASE
#define MK_PER_PHASE 0
#endif

constexpr int DM = 2048, BATCH = 4, SEQ = 2048, DEPTH = 2, CTX = 256;
constexpr int N_IN = 6656, N_MOD = 6144, HEADS = 8;
constexpr int TPB = CTX + SEQ;
constexpr int M_TOT = BATCH * TPB;
constexpr float EPS = 1e-6f;
constexpr int C_Q = 0, C_K = 1024, C_V = 2048, C_GA = 3072, C_UP = 4096, C_GP = 4608, C_CA = 5120, C_CB = 5632, C_GC = 6144;
constexpr int NWAVES = 8, NTHREADS = 512;

#define LAS __attribute__((address_space(3)))
#define GAS __attribute__((address_space(1)))
typedef unsigned short bf16_t;
typedef short bf16x8 __attribute__((ext_vector_type(8)));
typedef short s16x4 __attribute__((ext_vector_type(4)));
typedef float f32x4 __attribute__((ext_vector_type(4)));
typedef float f32x16 __attribute__((ext_vector_type(16)));
typedef unsigned u32x4 __attribute__((ext_vector_type(4)));
typedef unsigned u32x2 __attribute__((ext_vector_type(2)));

__device__ __forceinline__ float bf2f(bf16_t v) { return __uint_as_float(((unsigned)v) << 16); }
__device__ __forceinline__ unsigned f2bf(float f) { unsigned u = __float_as_uint(f); return (u + 0x7fffu + ((u >> 16) & 1u)) >> 16; }
__device__ __forceinline__ unsigned pk2(float lo, float hi) { return f2bf(lo) | (f2bf(hi) << 16); }
__device__ __forceinline__ unsigned cvt_pk_bf16(float lo, float hi) { unsigned r; asm volatile("v_cvt_pk_bf16_f32 %0, %1, %2" : "=v"(r) : "v"(lo), "v"(hi)); return r; }
__device__ __forceinline__ float silu_f(float v) { return v * __builtin_amdgcn_rcpf(1.f + __expf(-v)); }
__device__ __forceinline__ float sigm_f(float v) { return __builtin_amdgcn_rcpf(1.f + __expf(-v)); }
__device__ __forceinline__ float wave_sum(float v) {
#pragma unroll
    for (int o = 1; o < 64; o <<= 1) v += __shfl_xor(v, o);
    return v;
}

__device__ __forceinline__ int opaque_tid() { int t = threadIdx.x; asm volatile("" : "+v"(t)); return t; }

constexpr size_t MiB = 1u << 20;
constexpr size_t WS_CTL = 0, CTL_ZERO_BYTES = 64 * 1024;
constexpr size_t WS_ROPE = 512 * 1024;
constexpr size_t WS_MOD = 1 * MiB;
constexpr size_t WS_WIN = 2 * MiB;
constexpr size_t WS_WOUT = 54 * MiB;
constexpr size_t WS_WPW2 = 70 * MiB;
constexpr size_t WS_WPOOL = 71 * MiB;
constexpr size_t WS_CTXRES = 72 * MiB;
constexpr size_t WS_H = 80 * MiB;
constexpr size_t WS_P = 116 * MiB;
constexpr size_t WS_YMIX = 234 * MiB;
constexpr size_t WS_END = 270 * MiB;
constexpr int CW_BAR = 1024;

constexpr int RING_BYTES = 131072;
constexpr int LDSCTL_OFF = RING_BYTES, MISC_OFF = LDSCTL_OFF + 320;
constexpr int LDS_BYTES = 147456;

namespace pg8 {
constexpr int BM = 256, BK = 64, HALF = 128, HTB = HALF * BK * 2, STAGE_BYTES = 8 * HTB, NXCD = 8, WGM = 8;
__host__ __device__ __forceinline__ int lds_byte(int r, int c) { const int st = (r >> 4) * 2 + (c >> 5), rr = r & 15, cc = c & 31, ob = rr * 64 + cc * 2; return st * 1024 + (ob ^ (((ob >> 9) & 1) << 5)); }
__host__ __device__ __forceinline__ void stage_rc(int b, int& R, int& C) { const int st = b / 1024, sb = b % 1024, swz = sb ^ (((sb >> 9) & 1) << 5); R = (st >> 1) * 16 + swz / 64; C = (st & 1) * 32 + (swz % 64) / 2; }
__host__ __device__ __forceinline__ int perm32(int rho) { const int n = rho >> 4, i = rho & 15; return 8 * (i >> 2) + 4 * n + (i & 3); }

struct Unit { int pm, pn; };
struct Gemm { const bf16_t* A; const bf16_t* Bt; int M, N, K; };

struct TileSched {
    int nM, nN, nreg, nwg, G, c, lat_only;
    __device__ void init(int nM_, int nN_, int nextra, int lat_only_, int G_, int c_) { nM = nM_; nN = nN_; nreg = nM_ * nN_; nwg = nreg + nextra; lat_only = lat_only_; G = G_; c = c_; }
    __device__ bool next(int i, Unit& u) const {
        const long L = (long)i * G + c; if (L >= nwg) return false;
        int wgid = (int)L; { const int q = nwg / NXCD, r = nwg % NXCD, xcd = wgid % NXCD, off = wgid / NXCD; wgid = (xcd < r ? xcd * (q + 1) : r * (q + 1) + (xcd - r) * q) + off; }
        if (wgid < nreg) {
            const int nig = WGM * nN, gid = wgid / nig, fm = gid * WGM, gsz = (nM - fm) < WGM ? (nM - fm) : WGM;
            const int j = fm + ((wgid % nig) % gsz); u.pn = (wgid % nig) / gsz;
            u.pm = lat_only ? (j >> 3) * 9 + 1 + (j & 7) : j;
        } else { const int e = wgid - nreg; u.pm = (e >> 3) * 9; u.pn = 4 + (e & 7); }
        return true;
    }
    __device__ __forceinline__ void a_ready(const Unit&) const {}
    __device__ __forceinline__ void done(const Unit&) const {}
};

struct EpiIn {
    static constexpr bool PERM = false, AFTER_DRAIN = false;
    bf16_t* P; const float* rope;
    __device__ __forceinline__ void operator()(const f32x4 (&acc)[2][2][4][2], const Unit& u, int wr, int wc, int fr, int fq) const {
        const int bt = u.pm % 9; const bool do_rope = (u.pn < 8) && (bt != 0), glu = (u.pn >= 20) && (u.pn < 24);
        const int col0 = u.pn * BM + wc * 32 + 4 * fq;
#pragma unroll
        for (int ai = 0; ai < 2; ++ai)
#pragma unroll
            for (int m = 0; m < 4; ++m) {
                const int rl = ai * HALF + wr * 64 + m * 16 + fr; const size_t row = (size_t)u.pm * BM + rl;
                f32x4 cs = {1.f, 1.f, 1.f, 1.f}, sn = {0.f, 0.f, 0.f, 0.f};
                if (do_rope) { const int tl = (bt - 1) * 256 + rl, pos = (wc & 1) ? (tl & 63) : (tl >> 6);
                    const f32x4 a = *(const f32x4*)(rope + (pos * 16 + 4 * fq) * 2), b = *(const f32x4*)(rope + (pos * 16 + 4 * fq) * 2 + 4);
                    cs = (f32x4){a[0], a[2], b[0], b[2]}; sn = (f32x4){a[1], a[3], b[1], b[3]}; }
                bf16_t* rowp = P + row * N_IN + col0;
                if (glu) {
#pragma unroll
                    for (int bj = 0; bj < 2; ++bj) { const f32x4 v0 = acc[ai][bj][m][0], v1 = acc[ai][bj][m][1]; const int g32 = (u.pn - 20) * 8 + bj * 4 + wc;
                        u32x2 w0; w0.x = cvt_pk_bf16(v0[0] * sigm_f(v1[0]), v0[1] * sigm_f(v1[1])); w0.y = cvt_pk_bf16(v0[2] * sigm_f(v1[2]), v0[3] * sigm_f(v1[3]));
                        *(u32x2*)(P + row * N_IN + C_CA + g32 * 16 + 4 * fq) = w0; }
                } else {
#pragma unroll
                for (int bj = 0; bj < 2; ++bj) { const f32x4 v0 = acc[ai][bj][m][0], v1 = acc[ai][bj][m][1];
                    const f32x4 o0 = v0 * cs - v1 * sn, o1 = v1 * cs + v0 * sn;
                    u32x2 w0, w1; w0.x = cvt_pk_bf16(o0[0], o0[1]); w0.y = cvt_pk_bf16(o0[2], o0[3]); w1.x = cvt_pk_bf16(o1[0], o1[1]); w1.y = cvt_pk_bf16(o1[2], o1[3]);
                    *(u32x2*)(rowp + bj * HALF) = w0; *(u32x2*)(rowp + bj * HALF + 16) = w1; }
                }
            }
    }
};
struct EpiOut {
    static constexpr bool PERM = false, AFTER_DRAIN = false;
    const float* xin; const float* cin; float* xout; float* cout; const float* MODl;
    __device__ __forceinline__ void operator()(const f32x4 (&acc)[2][2][4][2], const Unit& u, int wr, int wc, int fr, int fq) const {
        const int bt = u.pm % 9, b = u.pm / 9; const bool lat = bt != 0;
        const int col0 = u.pn * BM + wc * 32 + 4 * fq;
        const float* gp = MODl + (size_t)(lat ? b : 4) * N_MOD + 4096 + col0;
        f32x4 gv[2][2];
#pragma unroll
        for (int bj = 0; bj < 2; ++bj)
#pragma unroll
            for (int n = 0; n < 2; ++n) gv[bj][n] = *(const f32x4*)(gp + bj * HALF + n * 16);
        const float* src = lat ? xin : cin; float* dst = lat ? xout : cout;
#pragma unroll
        for (int ai = 0; ai < 2; ++ai)
#pragma unroll
            for (int m = 0; m < 4; ++m) {
                const int rl = ai * HALF + wr * 64 + m * 16 + fr;
                const size_t off = (lat ? ((size_t)b * SEQ + (bt - 1) * 256 + rl) : ((size_t)b * CTX + rl)) * DM + col0;
#pragma unroll
                for (int bj = 0; bj < 2; ++bj)
#pragma unroll
                    for (int n = 0; n < 2; ++n) { const f32x4 old = *(const f32x4*)(src + off + bj * HALF + n * 16); *(f32x4*)(dst + off + bj * HALF + n * 16) = old + gv[bj][n] * acc[ai][bj][m][n]; }
            }
    }
};

template <class Epi, class Sched, bool ALIGN_EPI = false, bool SP2 = false>
__device__ __forceinline__ void gemm_phase(LAS unsigned char* lds, const Gemm g, const Sched& S, const Epi& E) {
    const int tid = opaque_tid(), wid = __builtin_amdgcn_readfirstlane(tid >> 6), lane = tid & 63, wr = wid >> 2, wc = wid & 3, fr = lane & 15, fq = lane >> 4;
    const int K = g.K, nt = K / BK;
    unsigned voffA[2], voffB[2];
#pragma unroll
    for (int i = 0; i < 2; ++i) { int R, C; stage_rc(tid * 16 + i * 8192, R, C); const int Rb = Epi::PERM ? ((R & ~31) + perm32(R & 31)) : R;
        voffA[i] = (unsigned)(R * K + C) * 2u; voffB[i] = (unsigned)(Rb * K + C) * 2u; }
    const size_t kstep = (size_t)(BK * 2);
    const size_t hstep = (size_t)HALF * K * 2;
    const size_t tstep = 2 * hstep;
    const unsigned ldsw = (unsigned)wid * 1024u;
    const int aoff = lds_byte(wr * 64 + fr, fq * 8), boff = lds_byte(wc * 32 + fr, fq * 8);
#define PG8_SA(b, h) (((b) * 2 + (h)) * HTB)
#define PG8_SB(b, h) ((4 + (b) * 2 + (h)) * HTB)
#define PG8_STAGE(bufoff, gbase, voff) do { _Pragma("unroll") for (int _i = 0; _i < 2; ++_i) \
        __builtin_amdgcn_global_load_lds((const unsigned*)((const char*)(gbase) + (voff)[_i]), (LAS unsigned*)(lds + (bufoff) + ldsw + _i * 8192), 16, 0, 0); } while (0)
#define PG8_LDA(dst, b, h) do { _Pragma("unroll") for (int m = 0; m < 4; ++m) _Pragma("unroll") for (int k = 0; k < 2; ++k) dst[m][k] = *(const LAS bf16x8*)(lds + PG8_SA(b, h) + aoff + m * 2048 + k * 1024); } while (0)
#define PG8_LDB(dst, b, h) do { _Pragma("unroll") for (int n = 0; n < 2; ++n) _Pragma("unroll") for (int k = 0; k < 2; ++k) dst[n][k] = *(const LAS bf16x8*)(lds + PG8_SB(b, h) + boff + n * 2048 + k * 1024); } while (0)
#define PG8_MMA(ai, bj, At, Bt) do { __builtin_amdgcn_s_setprio(1); _Pragma("unroll") for (int m = 0; m < 4; ++m) _Pragma("unroll") for (int n = 0; n < 2; ++n) _Pragma("unroll") for (int k = 0; k < 2; ++k) \
        acc[ai][bj][m][n] = __builtin_amdgcn_mfma_f32_16x16x32_bf16(Bt[n][k], At[m][k], acc[ai][bj][m][n], 0, 0, 0); __builtin_amdgcn_s_setprio(0); } while (0)
#define PG8_WAIT_V(n) asm volatile("s_waitcnt vmcnt(" #n ")" ::: "memory")
#define PG8_WAIT_L(n) asm volatile("s_waitcnt lgkmcnt(" #n ")" ::: "memory")
#define PG8_BAR __builtin_amdgcn_s_barrier()
#define PG8_SCHED __builtin_amdgcn_sched_barrier(0)
    Unit cur, nxt; int ui = 0;
    if (!S.next(0, cur)) return;
    f32x4 acc[2][2][4][2];
#pragma unroll
    for (int a = 0; a < 2; ++a)
#pragma unroll
        for (int b = 0; b < 2; ++b)
#pragma unroll
            for (int m = 0; m < 4; ++m)
#pragma unroll
                for (int n = 0; n < 2; ++n) acc[a][b][m][n] = (f32x4){0.f, 0.f, 0.f, 0.f};
    bf16x8 At[4][2], B0[2][2], B1[2][2];
    const char* cA = (const char*)g.A + (size_t)cur.pm * tstep; const char* cB = (const char*)g.Bt + (size_t)cur.pn * tstep;
    S.a_ready(cur);
    if constexpr (SP2) {
        PG8_STAGE(PG8_SB(0, 0), cB, voffB); PG8_STAGE(PG8_SB(0, 1), cB + hstep, voffB); PG8_STAGE(PG8_SA(0, 0), cA, voffA); PG8_STAGE(PG8_SA(0, 1), cA + hstep, voffA);
        if (wr == 1) PG8_BAR;
        PG8_WAIT_V(2); PG8_BAR;
        PG8_STAGE(PG8_SB(1, 0), cB + kstep, voffB); PG8_STAGE(PG8_SA(1, 0), cA + kstep, voffA); PG8_STAGE(PG8_SB(1, 1), cB + hstep + kstep, voffB);
        PG8_WAIT_V(6); PG8_BAR;
    } else {
        PG8_STAGE(PG8_SB(0, 0), cB, voffB); PG8_STAGE(PG8_SA(0, 0), cA, voffA); PG8_STAGE(PG8_SB(0, 1), cB + hstep, voffB); PG8_STAGE(PG8_SA(0, 1), cA + hstep, voffA);
        if (wr == 1) PG8_BAR;
        PG8_WAIT_V(4); PG8_BAR;
        PG8_STAGE(PG8_SB(1, 0), cB + kstep, voffB); PG8_STAGE(PG8_SA(1, 0), cA + kstep, voffA); PG8_STAGE(PG8_SB(1, 1), cB + hstep + kstep, voffB);
        PG8_WAIT_V(6); PG8_BAR;
    }
    for (;;) {
        const bool has_next = S.next(ui + 1, nxt);
        const char* nA = has_next ? (const char*)g.A + (size_t)nxt.pm * tstep : cA; const char* nB = has_next ? (const char*)g.Bt + (size_t)nxt.pn * tstep : cB;
        for (int t = 0; t < nt; t += 2) {
            const bool last = (t == nt - 2);
            const char* a1 = cA + (size_t)(t + 1) * kstep;
            const char* a2 = last ? nA : cA + (size_t)(t + 2) * kstep; const char* b2 = last ? nB : cB + (size_t)(t + 2) * kstep;
            const char* a3 = a2 + kstep; const char* b3 = b2 + kstep;
            if (last && has_next) S.a_ready(nxt);
            if constexpr (SP2) {
            PG8_LDB(B0, 0, 0); PG8_LDB(B1, 0, 1); PG8_SCHED; PG8_LDA(At, 0, 0); PG8_STAGE(PG8_SA(1, 1), a1 + hstep, voffA);
            PG8_WAIT_V(8); PG8_WAIT_L(0); PG8_BAR; PG8_MMA(0, 0, At, B0); PG8_MMA(0, 1, At, B1); PG8_BAR; PG8_SCHED;
            PG8_LDA(At, 0, 1); PG8_STAGE(PG8_SB(0, 0), b2, voffB); PG8_STAGE(PG8_SB(0, 1), b2 + hstep, voffB); PG8_STAGE(PG8_SA(0, 0), a2, voffA);
            PG8_WAIT_V(8); PG8_WAIT_L(0); PG8_BAR; PG8_MMA(1, 0, At, B0); PG8_MMA(1, 1, At, B1); PG8_BAR; PG8_SCHED;
            PG8_LDB(B0, 1, 0); PG8_LDB(B1, 1, 1); PG8_SCHED; PG8_LDA(At, 1, 0); PG8_STAGE(PG8_SA(0, 1), a2 + hstep, voffA);
            PG8_WAIT_V(8); PG8_WAIT_L(0); PG8_BAR; PG8_MMA(0, 0, At, B0); PG8_MMA(0, 1, At, B1); PG8_BAR; PG8_SCHED;
            PG8_LDA(At, 1, 1); PG8_STAGE(PG8_SB(1, 0), b3, voffB); PG8_STAGE(PG8_SB(1, 1), b3 + hstep, voffB); PG8_STAGE(PG8_SA(1, 0), a3, voffA);
            PG8_WAIT_V(8); PG8_WAIT_L(0); PG8_BAR; PG8_MMA(1, 0, At, B0); PG8_MMA(1, 1, At, B1); PG8_BAR; PG8_SCHED;
            } else {
            PG8_LDB(B0, 0, 0); PG8_SCHED; PG8_LDA(At, 0, 0); PG8_STAGE(PG8_SA(1, 1), a1 + hstep, voffA);
            PG8_WAIT_L(8); PG8_BAR; PG8_WAIT_L(0); PG8_MMA(0, 0, At, B0); PG8_BAR; PG8_SCHED;
            PG8_LDB(B1, 0, 1); PG8_STAGE(PG8_SB(0, 0), b2, voffB);
            PG8_BAR; PG8_WAIT_L(0); PG8_MMA(0, 1, At, B1); PG8_BAR;
            PG8_LDA(At, 0, 1); PG8_STAGE(PG8_SA(0, 0), a2, voffA);
            PG8_BAR; PG8_WAIT_L(0); PG8_MMA(1, 0, At, B0); PG8_BAR; PG8_SCHED;
            PG8_STAGE(PG8_SB(0, 1), b2 + hstep, voffB);
            PG8_WAIT_V(6); PG8_BAR; PG8_MMA(1, 1, At, B1); PG8_BAR;
            PG8_LDB(B0, 1, 0); PG8_SCHED; PG8_LDA(At, 1, 0); PG8_STAGE(PG8_SA(0, 1), a2 + hstep, voffA);
            PG8_WAIT_L(8); PG8_BAR; PG8_WAIT_L(0); PG8_MMA(0, 0, At, B0); PG8_BAR; PG8_SCHED;
            PG8_LDB(B1, 1, 1); PG8_STAGE(PG8_SB(1, 0), b3, voffB);
            PG8_BAR; PG8_WAIT_L(0); PG8_MMA(0, 1, At, B1); PG8_BAR;
            PG8_LDA(At, 1, 1); PG8_STAGE(PG8_SA(1, 0), a3, voffA);
            PG8_BAR; PG8_WAIT_L(0); PG8_MMA(1, 0, At, B0); PG8_BAR; PG8_SCHED;
            PG8_STAGE(PG8_SB(1, 1), b3 + hstep, voffB);
            PG8_WAIT_V(6); PG8_BAR; PG8_MMA(1, 1, At, B1); PG8_BAR;
            }
        }
        if constexpr (ALIGN_EPI) { if (wr == 0) PG8_BAR; }
        if constexpr (!Epi::AFTER_DRAIN) { E(acc, cur, wr, wc, fr, fq); S.done(cur); }
        if (!has_next) break;
#pragma unroll
        for (int a = 0; a < 2; ++a)
#pragma unroll
            for (int b = 0; b < 2; ++b)
#pragma unroll
                for (int m = 0; m < 4; ++m)
#pragma unroll
                    for (int n = 0; n < 2; ++n) acc[a][b][m][n] = (f32x4){0.f, 0.f, 0.f, 0.f};
        cur = nxt; cA = nA; cB = nB; ++ui;
        if constexpr (ALIGN_EPI) { if (wr == 1) PG8_BAR; }
    }
    PG8_WAIT_V(0);
    if constexpr (!ALIGN_EPI) { if (wr == 0) PG8_BAR; }
    PG8_BAR;
#undef PG8_SA
#undef PG8_SB
#undef PG8_STAGE
#undef PG8_LDA
#undef PG8_LDB
#undef PG8_MMA
#undef PG8_WAIT_V
#undef PG8_WAIT_L
#undef PG8_BAR
#undef PG8_SCHED
}
}

namespace att {
constexpr int KVBLK = 64;
constexpr int SHM_V = KVBLK * 128 * 2, SHM_K = KVBLK * 128 * 2;
constexpr int OFF_V = 0, OFF_K = 2 * SHM_V, OFF_WS = 2 * SHM_V + 2 * SHM_K, ATT_LDS = OFF_WS + NWAVES * 64 * 4;
constexpr float SCALE = 0.125f, THR = 8.f;
#define KSWZ(row, colB) ((row) * 256 + ((colB) ^ (((row) & 7) << 4)))
#define SBAR() __builtin_amdgcn_sched_barrier(0)
__device__ __forceinline__ int crow(int r, int hi) { return (r & 3) + 8 * (r >> 2) + 4 * hi; }
__device__ __forceinline__ void partialSM(f32x16& p0, f32x16& p1, float& m_reg, float& mn, float& alpha) {
    constexpr float C = SCALE * 1.4426950408889634f;
    float pmax = p0[0];
#pragma unroll
    for (int r = 1; r < 16; ++r) pmax = fmaxf(pmax, p0[r]);
#pragma unroll
    for (int r = 0; r < 16; ++r) pmax = fmaxf(pmax, p1[r]);
    { auto rr = __builtin_amdgcn_permlane32_swap(__float_as_uint(pmax), __float_as_uint(pmax), false, false);
      pmax = fmaxf(__uint_as_float(rr[0]), __uint_as_float(rr[1])); }
    if (__builtin_expect(__all(pmax - m_reg <= THR / SCALE), 1)) { mn = m_reg; alpha = 1.f; }
    else { mn = fmaxf(m_reg, pmax); alpha = __builtin_amdgcn_exp2f((m_reg - mn) * C); m_reg = mn; }
    const float mnC = -mn * C;
#pragma unroll
    for (int r = 0; r < 16; ++r) p0[r] = fmaf(p0[r], C, mnC);
#pragma unroll
    for (int r = 0; r < 16; ++r) p1[r] = fmaf(p1[r], C, mnC);
#pragma unroll
    for (int r = 0; r < 16; ++r) p0[r] = __builtin_amdgcn_exp2f(p0[r]);
}
__device__ __forceinline__ void finishSM(f32x16& p0, f32x16& p1, float alpha, float& l_reg, bf16x8& pa0, bf16x8& pa1, bf16x8& pa2, bf16x8& pa3) {
#pragma unroll
    for (int r = 0; r < 16; ++r) p1[r] = __builtin_amdgcn_exp2f(p1[r]);
    float ps = 0;
#pragma unroll
    for (int r = 0; r < 16; ++r) ps += p0[r];
#pragma unroll
    for (int r = 0; r < 16; ++r) ps += p1[r];
    { auto rr = __builtin_amdgcn_permlane32_swap(__float_as_uint(ps), __float_as_uint(ps), false, false);
      ps = __uint_as_float(rr[0]) + __uint_as_float(rr[1]); }
    l_reg = l_reg * alpha + ps;
#define PK4(P, BASE, OUT) do { unsigned a0 = cvt_pk_bf16(P[BASE + 0], P[BASE + 1]), a1 = cvt_pk_bf16(P[BASE + 2], P[BASE + 3]);   \
    unsigned b0 = cvt_pk_bf16(P[BASE + 4], P[BASE + 5]), b1 = cvt_pk_bf16(P[BASE + 6], P[BASE + 7]);                              \
    auto r0 = __builtin_amdgcn_permlane32_swap(a0, b0, false, false); auto r1 = __builtin_amdgcn_permlane32_swap(a1, b1, false, false); \
    u32x4 w = {r0[0], r1[0], r0[1], r1[1]}; OUT = *reinterpret_cast<bf16x8*>(&w); } while (0)
    PK4(p0, 0, pa0); PK4(p0, 8, pa1); PK4(p1, 0, pa2); PK4(p1, 8, pa3);
#undef PK4
}
__device__ __forceinline__ void qkt(f32x16& p0, f32x16& p1, const char* Ks, const bf16x8* qr, int r32, int hi, int cbase) {
    p0 = f32x16{}; p1 = f32x16{};
#pragma unroll
    for (int d0 = 0; d0 < 4; ++d0) { const int cb = cbase + (d0 * 16 + hi * 8) * 2;
        const bf16x8 b0 = *reinterpret_cast<const bf16x8*>(Ks + KSWZ(r32, cb));
        const bf16x8 b1 = *reinterpret_cast<const bf16x8*>(Ks + KSWZ(32 + r32, cb));
        p0 = __builtin_amdgcn_mfma_f32_32x32x16_bf16(b0, qr[d0], p0, 0, 0, 0);
        p1 = __builtin_amdgcn_mfma_f32_32x32x16_bf16(b1, qr[d0], p1, 0, 0, 0); }
}
__device__ __forceinline__ int v_st(int k, int c) { const int kk = (k & ~0xC) | ((k & 4) << 1) | ((k & 8) >> 1); return ((kk >> 3) * 4 + (c >> 5)) * 512 + ((kk & 7) * 32 + (c & 31)) * 2; }
__device__ __forceinline__ int v_rd_base(int lane) { return ((lane & 3) << 3) | (((lane >> 2) & 3) << 6) | (((lane >> 4) & 1) << 5) | (((lane >> 5) & 1) << 8); }
constexpr int v_rd_off(int d0, int ks, int half) { return d0 * 512 + ks * 4096 + half * 2048; }
template <int OFF> __device__ __forceinline__ s16x4 tr_read(int vb) {
    s16x4 r; asm volatile("ds_read_b64_tr_b16 %0, %1 offset:%2" : "=&v"(r) : "v"(vb), "i"(OFF) : "memory"); return r;
}
template <int D0> __device__ __forceinline__ void pv_one(f32x16& od, int vb, bf16x8 pa0, bf16x8 pa1, bf16x8 pa2, bf16x8 pa3) {
    const s16x4 l0 = tr_read<v_rd_off(D0, 0, 0)>(vb), h0 = tr_read<v_rd_off(D0, 0, 1)>(vb), l1 = tr_read<v_rd_off(D0, 1, 0)>(vb), h1 = tr_read<v_rd_off(D0, 1, 1)>(vb);
    const s16x4 l2 = tr_read<v_rd_off(D0, 2, 0)>(vb), h2 = tr_read<v_rd_off(D0, 2, 1)>(vb), l3 = tr_read<v_rd_off(D0, 3, 0)>(vb), h3 = tr_read<v_rd_off(D0, 3, 1)>(vb);
    asm volatile("s_waitcnt lgkmcnt(0)" ::: "memory"); SBAR();
#define PK(L, H) (bf16x8){L[0], L[1], L[2], L[3], H[0], H[1], H[2], H[3]}
    od = __builtin_amdgcn_mfma_f32_32x32x16_bf16(pa0, PK(l0, h0), od, 0, 0, 0);
    od = __builtin_amdgcn_mfma_f32_32x32x16_bf16(pa1, PK(l1, h1), od, 0, 0, 0);
    od = __builtin_amdgcn_mfma_f32_32x32x16_bf16(pa2, PK(l2, h2), od, 0, 0, 0);
    od = __builtin_amdgcn_mfma_f32_32x32x16_bf16(pa3, PK(l3, h3), od, 0, 0, 0);
#undef PK
}
__device__ __forceinline__ void pv_d0(f32x16* o, int vb, bf16x8 pa0, bf16x8 pa1, bf16x8 pa2, bf16x8 pa3) {
    pv_one<0>(o[0], vb, pa0, pa1, pa2, pa3); pv_one<1>(o[1], vb, pa0, pa1, pa2, pa3); pv_one<2>(o[2], vb, pa0, pa1, pa2, pa3); pv_one<3>(o[3], vb, pa0, pa1, pa2, pa3);
}

__device__ __forceinline__ void attn_unit(const bf16_t* __restrict__ P, bf16_t* __restrict__ Y, int qrow0, int krow0, int nkeys, int h, float lam, float osc, const float* __restrict__ subln_g, char* lds, unsigned long long* g_ts) {
    const int tid = opaque_tid(), wid = tid >> 6, lane = tid & 63, r32 = lane & 31, hi = lane >> 5, rg = wid & 3, comp = wid >> 2;
    char* V_lds = lds + OFF_V; char* K_lds = lds + OFF_K;
    float* ws = (float*)(lds + OFF_WS) + wid * 64; float* li_l = ws; float* al_l = ws + 32;
    float m_reg = -1e30f, l_reg = 0; f32x16 o[4] = {}; bf16x8 qr[4];
    const bf16_t* Qw = P + (size_t)(qrow0 + rg * 32 + r32) * N_IN + C_Q + h * 128 + comp * 64 + hi * 8;
#pragma unroll
    for (int d0 = 0; d0 < 4; ++d0) qr[d0] = *reinterpret_cast<const bf16x8*>(Qw + d0 * 16);
    const bf16_t* Kh = P + (size_t)krow0 * N_IN + C_K + h * 128; const bf16_t* Vh = P + (size_t)krow0 * N_IN + C_V + h * 128;
    const int sr = tid >> 4, sc = (tid & 15) * 8, vst0 = v_st(sr, sc), vst1 = v_st(32 + sr, sc);
    const int vb0 = (int)(uintptr_t)V_lds + v_rd_base(lane);
    const int cbase = comp * 128;
    struct { bf16x8 vs0, vs1, ks0, ks1; } sr_[2];
#define SLOAD(i, k0) do { sr_[i].vs0 = *reinterpret_cast<const bf16x8*>(&Vh[(size_t)((k0) + sr) * N_IN + sc]); sr_[i].vs1 = *reinterpret_cast<const bf16x8*>(&Vh[(size_t)((k0) + 32 + sr) * N_IN + sc]); \
    sr_[i].ks0 = *reinterpret_cast<const bf16x8*>(&Kh[(size_t)((k0) + sr) * N_IN + sc]); sr_[i].ks1 = *reinterpret_cast<const bf16x8*>(&Kh[(size_t)((k0) + 32 + sr) * N_IN + sc]); } while (0)
#define SWRITE(b, i) do { *(bf16x8*)(V_lds + (b) * SHM_V + vst0) = sr_[i].vs0; *(bf16x8*)(V_lds + (b) * SHM_V + vst1) = sr_[i].vs1; const int kc = sc * 2; \
    *(bf16x8*)(K_lds + (b) * SHM_K + KSWZ(sr, kc)) = sr_[i].ks0; *(bf16x8*)(K_lds + (b) * SHM_K + KSWZ(32 + sr, kc)) = sr_[i].ks1; } while (0)
#define SWAIT() asm volatile("s_waitcnt vmcnt(4)" ::: "memory")
#define RESC(a) do { if (__any((a) < 1.f)) { if (hi == 0) al_l[r32] = (a); asm volatile("s_waitcnt lgkmcnt(0)" ::: "memory"); \
    _Pragma("unroll") for (int d = 0; d < 4; ++d) _Pragma("unroll") for (int r = 0; r < 16; ++r) o[d][r] *= al_l[crow(r, hi)]; } } while (0)
    f32x16 pA0, pA1, pB0, pB1; float mnA, mnB, alA, alB; bf16x8 pa0, pa1, pa2, pa3; const int NT = nkeys / KVBLK;
    constexpr int SE = 0, SO = 1;
    SLOAD(SE, 0); asm volatile("s_waitcnt vmcnt(0)" ::: "memory"); SWRITE(0, SE); __syncthreads();
    qkt(pA0, pA1, K_lds, qr, r32, hi, cbase); partialSM(pA0, pA1, m_reg, mnA, alA);
    SLOAD(SO, KVBLK); if (2 < NT) SLOAD(SE, 2 * KVBLK);
    SWAIT(); SWRITE(1, SO); __syncthreads();
    for (int j = 1; j + 1 < NT; j += 2) {
        SBAR(); qkt(pB0, pB1, K_lds + SHM_K, qr, r32, hi, cbase);
        finishSM(pA0, pA1, alA, l_reg, pa0, pa1, pa2, pa3); SBAR();
        SLOAD(SO, (j + 2) * KVBLK); SBAR();
        pv_d0(o, vb0, pa0, pa1, pa2, pa3); partialSM(pB0, pB1, m_reg, mnB, alB);
        __syncthreads(); SWAIT(); SWRITE(0, SE);
        RESC(alB); __syncthreads();
        SBAR(); qkt(pA0, pA1, K_lds, qr, r32, hi, cbase);
        finishSM(pB0, pB1, alB, l_reg, pa0, pa1, pa2, pa3); SBAR();
        if (j + 3 < NT) SLOAD(SE, (j + 3) * KVBLK); SBAR();
        pv_d0(o, vb0 + SHM_V, pa0, pa1, pa2, pa3); partialSM(pA0, pA1, m_reg, mnA, alA);
        __syncthreads(); SWAIT(); SWRITE(1, SO);
        RESC(alA); __syncthreads();
    }
    SBAR(); qkt(pB0, pB1, K_lds + SHM_K, qr, r32, hi, cbase);
    finishSM(pA0, pA1, alA, l_reg, pa0, pa1, pa2, pa3); SBAR();
    pv_d0(o, vb0, pa0, pa1, pa2, pa3); partialSM(pB0, pB1, m_reg, mnB, alB);
    __syncthreads(); RESC(alB);
    finishSM(pB0, pB1, alB, l_reg, pa0, pa1, pa2, pa3); SBAR();
    pv_d0(o, vb0 + SHM_V, pa0, pa1, pa2, pa3);
    if (hi == 0) li_l[r32] = l_reg; asm volatile("s_waitcnt lgkmcnt(0)" ::: "memory");
#pragma unroll
    for (int r = 0; r < 16; ++r) { const float rl = __builtin_amdgcn_rcpf(li_l[crow(r, hi)]);
#pragma unroll
        for (int d0 = 0; d0 < 4; ++d0) o[d0][r] *= rl; }
    __syncthreads();
    float* X = (float*)lds + (size_t)rg * 64 * 64 + lane;
    if (comp == 1) {
#pragma unroll
        for (int d0 = 0; d0 < 4; ++d0)
#pragma unroll
            for (int r = 0; r < 16; ++r) X[(d0 * 16 + r) * 64] = o[d0][r];
    }
    __syncthreads();
    if (comp == 0) {
        float rs[16];
#pragma unroll
        for (int r = 0; r < 16; ++r) { float ss = 0.f;
#pragma unroll
            for (int d0 = 0; d0 < 4; ++d0) { o[d0][r] -= lam * X[(d0 * 16 + r) * 64]; ss += o[d0][r] * o[d0][r]; }
#pragma unroll
            for (int x = 1; x < 32; x <<= 1) ss += __shfl_xor(ss, x);
            rs[r] = rsqrtf(ss * (1.f / 128.f) + EPS) * osc; }
#pragma unroll
        for (int d0 = 0; d0 < 4; ++d0) { const int col = d0 * 32 + r32; const float sg = subln_g[col];
#pragma unroll
            for (int r = 0; r < 16; ++r) { const size_t row = (size_t)(qrow0 + rg * 32 + crow(r, hi));
                const float g = bf2f(P[row * N_IN + C_GA + h * 128 + col]);
                Y[row * DM + h * 128 + col] = (bf16_t)f2bf(o[d0][r] * rs[r] * sg * silu_f(g)); } }
    }
    __syncthreads();
#undef SLOAD
#undef SWRITE
#undef SWAIT
#undef RESC
}
#undef KSWZ
#undef SBAR
}

namespace mixu {
constexpr int TT = 32;
constexpr int OFF_A = 0;
constexpr int OFF_B = 65536;
constexpr int AB_STRIDE = 1040;
struct Args { const bf16_t* P; bf16_t* Y; const bf16_t* wpool_t; const float* pool_scale; const float* w_dw; const float* b_dw; const float* ln_g; const float* ln_b; const bf16_t* wpw2_t; };
__device__ __forceinline__ float bflo(unsigned w) { return __uint_as_float(w << 16); }
__device__ __forceinline__ float bfhi(unsigned w) { return __uint_as_float(w & 0xffff0000u); }
__device__ __forceinline__ float ldsbf(const LAS unsigned char* p) { return bf2f(*(const LAS bf16_t*)p); }

__device__ __forceinline__ void wave_sum4(float (&v)[4]) {
#pragma unroll
    for (int o = 1; o < 64; o <<= 1) {
#pragma unroll
        for (int q = 0; q < 4; ++q) v[q] += __shfl_xor(v[q], o); }
}
__device__ __forceinline__ void mix_unit(const Args& a, int row0, LAS unsigned char* lds, unsigned long long* g_ts) {
    const int tid = opaque_tid(), wid = __builtin_amdgcn_readfirstlane(tid >> 6), lane = tid & 63, fr = lane & 15, fq = lane >> 4;
    const int b = row0 / TPB, t0 = row0 % TPB; const bool isctx = t0 < CTX;
    const int seq0 = b * TPB + (isctx ? 0 : CTX), L = isctx ? CTX : SEQ, tl0 = isctx ? t0 : t0 - CTX;
    LAS unsigned char* rA = lds + OFF_A; LAS unsigned char* rB = lds + OFF_B; LAS float* ys = (LAS float*)rB;
    const bf16_t* P = a.P;
    const int g = wid >> 1, nh = wid & 1;
    STAMP(59);
    bf16x8 bfr[4][4]; u32x2 gwp[4][2]; f32x4 ps[4]; float w[31];
    { const bf16_t* wt = a.wpool_t + (size_t)g * 128 * 128 + (size_t)(nh * 4) * 4 * 512 + lane * 8;
#pragma unroll
      for (int nb = 0; nb < 4; ++nb) {
#pragma unroll
          for (int ks = 0; ks < 4; ++ks) bfr[nb][ks] = *(const bf16x8*)(wt + (nb * 4 + ks) * 512); } }
#pragma unroll
    for (int j = 0; j < 31; ++j) w[j] = a.w_dw[j * 512 + tid];
    const float bias = a.b_dw[tid];
#pragma unroll 1
    for (int i = 0; i < 14; ++i) {
        const bool up = i < 6; const int p = (up ? i : i - 6) * 8 + wid, tl = tl0 - (up ? 8 : 15) + p;
        LAS unsigned char* dst = (up ? rB : rA) + p * 1024;
        if (up || p < TT + 30) {
            if (tl >= 0 && tl < L) __builtin_amdgcn_global_load_lds((const unsigned*)(P + (size_t)(seq0 + tl) * N_IN + (up ? C_UP : C_CA) + lane * 8), (LAS unsigned*)dst, 16, 0, 0);
            else { unsigned z = 0u; asm volatile("" : "+v"(z)); *(LAS u32x4*)(dst + lane * 16) = (u32x4){z, z, z, z}; }
        }
    }
    STAMP(60);
    asm volatile("s_waitcnt vmcnt(0)" ::: "memory");
    __syncthreads();
    STAMP(61);
#pragma unroll
    for (int nb = 0; nb < 4; ++nb) { const int n = g * 128 + nh * 64 + nb * 16 + fq * 4; ps[nb] = *(const f32x4*)(a.pool_scale + n);
#pragma unroll
        for (int m = 0; m < 2; ++m) gwp[nb][m] = *(const u32x2*)(P + ((size_t)row0 + m * 16 + fr) * N_IN + C_GP + n); }
    { const int HW = 1 << (wid >> 1); LAS unsigned char* col = rB + tid * 2; float s = 0.f;
      for (int p = 0; p < 2 * HW; ++p) s += ldsbf(col + (8 - HW + p) * 1024);
#pragma unroll 8
      for (int tk = 0; tk < TT; ++tk) { const int tl = tl0 + tk, lo = max(tl - HW, 0), hi = min(tl + HW, L);
          const float d = s * __builtin_amdgcn_rcpf((float)(hi - lo)) - ldsbf(col + (8 + tk) * 1024);
          s += ldsbf(col + (8 + HW + tk) * 1024) - ldsbf(col + (8 - HW + tk) * 1024);
          *(LAS bf16_t*)(col + tk * 1024) = (bf16_t)f2bf(d); } }
    __syncthreads();
    STAMP(62);
    { bf16x8 af[2][4];
#pragma unroll
      for (int m = 0; m < 2; ++m)
#pragma unroll
          for (int ks = 0; ks < 4; ++ks) af[m][ks] = *(const LAS bf16x8*)(rB + (m * 16 + fr) * 1024 + (g * 128 + ks * 32 + fq * 8) * 2);
#pragma unroll
      for (int nb = 0; nb < 4; ++nb) { const int n = g * 128 + nh * 64 + nb * 16 + fq * 4;
#pragma unroll
          for (int m = 0; m < 2; ++m) { f32x4 acc = {0.f, 0.f, 0.f, 0.f};
#pragma unroll
              for (int ks = 0; ks < 4; ++ks) acc = __builtin_amdgcn_mfma_f32_16x16x32_bf16(bfr[nb][ks], af[m][ks], acc, 0, 0, 0);
              const f32x4 v = acc * ps[nb]; const u32x2 gw = gwp[nb][m];
              u32x2 o; o.x = pk2(v[0] * silu_f(bflo(gw.x)), v[1] * silu_f(bfhi(gw.x))); o.y = pk2(v[2] * silu_f(bflo(gw.y)), v[3] * silu_f(bfhi(gw.y)));
              *(u32x2*)(a.Y + ((size_t)row0 + m * 16 + fr) * DM + 1024 + n) = o; } } }
    const bf16_t* wt2 = a.wpw2_t + (size_t)(wid * 4) * 16 * 512 + lane * 8;
    bf16x8 bcur[16], bnxt[16]; u32x2 gcur[2], gnxt[2];
#pragma unroll
    for (int ks = 0; ks < 16; ++ks) bcur[ks] = *(const bf16x8*)(wt2 + ks * 512);
#pragma unroll
    for (int m = 0; m < 2; ++m) gcur[m] = *(const u32x2*)(P + ((size_t)row0 + m * 16 + fr) * N_IN + C_GC + wid * 64 + fq * 4);
    __syncthreads();
    STAMP(63);
    { const LAS unsigned char* ucol = rA + tid * 2; float win[34];
#pragma unroll
      for (int i = 0; i < 30; ++i) win[i] = ldsbf(ucol + i * 1024);
#pragma unroll 1
      for (int it = 0; it < TT / 4; ++it) {
#pragma unroll
          for (int k = 0; k < 4; ++k) win[30 + k] = ldsbf(ucol + (30 + 4 * it + k) * 1024);
#pragma unroll
          for (int k = 0; k < 4; ++k) { float y = bias;
#pragma unroll
              for (int j = 0; j < 31; ++j) y += win[k + j] * w[j];
              ys[(4 * it + k) * 512 + tid] = y; }
#pragma unroll
          for (int i = 0; i < 30; ++i) win[i] = win[i + 4];
      } }
    __syncthreads();
    STAMP(64);
    { float v[4][8], s[4], qq[4];
#pragma unroll
      for (int q = 0; q < 4; ++q) { s[q] = 0.f;
#pragma unroll
          for (int j = 0; j < 8; ++j) { v[q][j] = ys[(wid * 4 + q) * 512 + lane + 64 * j]; s[q] += v[q][j]; } }
      wave_sum4(s);
#pragma unroll
      for (int q = 0; q < 4; ++q) { const float mu = s[q] * (1.f / 512.f); qq[q] = 0.f;
#pragma unroll
          for (int j = 0; j < 8; ++j) { v[q][j] -= mu; qq[q] += v[q][j] * v[q][j]; } }
      wave_sum4(qq);
#pragma unroll
      for (int j = 0; j < 8; ++j) { const int c = lane + 64 * j; const float lg = a.ln_g[c], lb = a.ln_b[c];
#pragma unroll
          for (int q = 0; q < 4; ++q) { const float rs = rsqrtf(qq[q] * (1.f / 512.f) + EPS), z = v[q][j] * rs * lg + lb;
              *(LAS bf16_t*)(rA + (wid * 4 + q) * AB_STRIDE + c * 2) = (bf16_t)f2bf(silu_f(z)); } } }
    __syncthreads();
    STAMP(65);
#pragma unroll 1
    for (int nb = 0; nb < 4; ++nb) {
        const int nn = min(nb + 1, 3);
#pragma unroll
        for (int ks = 0; ks < 16; ++ks) bnxt[ks] = *(const bf16x8*)(wt2 + (nn * 16 + ks) * 512);
#pragma unroll
        for (int m = 0; m < 2; ++m) gnxt[m] = *(const u32x2*)(P + ((size_t)row0 + m * 16 + fr) * N_IN + C_GC + wid * 64 + nn * 16 + fq * 4);
        const int n = wid * 64 + nb * 16 + fq * 4;
        f32x4 acc[2] = {(f32x4){0.f, 0.f, 0.f, 0.f}, (f32x4){0.f, 0.f, 0.f, 0.f}};
#pragma unroll
        for (int ks = 0; ks < 16; ++ks)
#pragma unroll
            for (int m = 0; m < 2; ++m) { const bf16x8 af = *(const LAS bf16x8*)(rA + (m * 16 + fr) * AB_STRIDE + (ks * 32 + fq * 8) * 2);
                acc[m] = __builtin_amdgcn_mfma_f32_16x16x32_bf16(bcur[ks], af, acc[m], 0, 0, 0); }
#pragma unroll
        for (int m = 0; m < 2; ++m) { const f32x4 v = acc[m];
            u32x2 o; o.x = pk2(v[0] * silu_f(bflo(gcur[m].x)), v[1] * silu_f(bfhi(gcur[m].x))); o.y = pk2(v[2] * silu_f(bflo(gcur[m].y)), v[3] * silu_f(bfhi(gcur[m].y)));
            *(u32x2*)(a.Y + ((size_t)row0 + m * 16 + fr) * DM + 1536 + n) = o; }
#pragma unroll
        for (int ks = 0; ks < 16; ++ks) bcur[ks] = bnxt[ks];
        gcur[0] = gnxt[0]; gcur[1] = gnxt[1];
    }
    __syncthreads();
    STAMP(66);
}
}

#define XB_TMO      128
#define XB_XCNT(j)  (256  + 64 * (j))
#define XB_XSUB(j)  (1280 + 64 * (j))
#define XB_XGEN(j)  (2304 + 64 * (j))
#define XB_TOP      3328
#define XB_TOPGEN   3392
#define XCD_BAR_WORDS 3456
#define XB_SPIN_CAP (1u << 18)
__device__ __forceinline__ unsigned xb_ld(unsigned* p)              { return __hip_atomic_load(p, __ATOMIC_RELAXED, __HIP_MEMORY_SCOPE_AGENT); }
__device__ __forceinline__ unsigned xb_add(unsigned* p, unsigned v) { return __hip_atomic_fetch_add(p, v, __ATOMIC_RELAXED, __HIP_MEMORY_SCOPE_AGENT); }
__device__ __forceinline__ unsigned xb_xcc_id() { return (unsigned)__builtin_amdgcn_s_getreg((3 << 11) | 20) & 0xFu; }
#define XB_SPIN(cond, bar) do { unsigned _sp = 0; while (cond) { __builtin_amdgcn_s_sleep(1); \
    if ((++_sp & 255u) == 0u) { if (xb_ld(&(bar)[XB_TMO])) break; if (_sp > XB_SPIN_CAP) { atomicAdd(&(bar)[XB_TMO], 1u); break; } } } } while (0)
struct XcdBarrier { unsigned* bar; unsigned x; volatile LAS unsigned* st; };
__device__ __forceinline__ XcdBarrier xcd_barrier_post(unsigned* bar, volatile LAS unsigned* st) {
    XcdBarrier b; b.bar = bar; b.x = xb_xcc_id(); b.st = st;
    if (threadIdx.x == 0) (void)xb_add(&bar[XB_XCNT(b.x)], 1u);
    return b;
}
__device__ __forceinline__ void xcd_barrier_complete(unsigned* bar, unsigned x, unsigned& nloc, unsigned& nx) {
    const unsigned G = gridDim.x * gridDim.y * gridDim.z;
    unsigned sum, cnt, mine, sp = 0u;
    for (;;) {
        sum = 0u; cnt = 0u; mine = 0u;
#pragma unroll
        for (unsigned j = 0; j < 16; ++j) { const unsigned c = xb_ld(&bar[XB_XCNT(j)]); sum += c; cnt += (c > 0u) ? 1u : 0u; mine = (j == x) ? c : mine; }
        if (sum == G) break;
        __builtin_amdgcn_s_sleep(1);
        if ((++sp & 255u) == 0u) { if (xb_ld(&bar[XB_TMO])) break; if (sp > XB_SPIN_CAP) { atomicAdd(&bar[XB_TMO], 1u); break; } }
    }
    nloc = mine > 0u ? mine : 1u; nx = cnt > 0u ? cnt : 1u;
}
__device__ __forceinline__ void xcd_barrier(const XcdBarrier& b) {
    asm volatile("s_waitcnt vmcnt(0)" ::: "memory");
    __syncthreads();
    if (threadIdx.x == 0) {
        unsigned* bar = b.bar;
        __builtin_amdgcn_s_waitcnt(0);
        unsigned nloc = b.st[0], nx = b.st[1];
        if (nloc == 0u) { xcd_barrier_complete(bar, b.x, nloc, nx); b.st[0] = nloc; b.st[1] = nx; }
        const unsigned old = xb_add(&bar[XB_XSUB(b.x)], 1u);
        const unsigned gen = old / nloc;
        if (old + 1u == (gen + 1u) * nloc) {
            __builtin_amdgcn_fence(__ATOMIC_RELEASE, "agent");
            asm volatile("s_waitcnt vmcnt(0)" ::: "memory");
            const unsigned og = xb_add(&bar[XB_TOP], 1u);
            const unsigned tg = og / nx;
            if (og + 1u == (tg + 1u) * nx) xb_add(&bar[XB_TOPGEN], 1u);
            else XB_SPIN(xb_ld(&bar[XB_TOPGEN]) == tg, bar);
            __builtin_amdgcn_fence(__ATOMIC_ACQUIRE, "agent");
            xb_add(&bar[XB_XGEN(b.x)], 1u);
            asm volatile("s_waitcnt vmcnt(0)" ::: "memory");
        } else {
            XB_SPIN(xb_ld(&bar[XB_XGEN(b.x)]) == gen, bar);
            __builtin_amdgcn_fence(__ATOMIC_ACQUIRE, "agent");
            asm volatile("s_waitcnt vmcnt(0)" ::: "memory");
        }
    }
    __syncthreads();
}

__device__ __forceinline__ int win_dest_row(int n) { if (n < C_CA || n >= C_GC) return n; const int isb = n >= C_CB ? 1 : 0, c = n - (isb ? C_CB : C_CA); return C_CA + (c >> 4) * 32 + (isb << 4) + (c & 15); }
__device__ __forceinline__ size_t frag_off(int n, int k, int nks) { return ((size_t)(((n >> 6) * 4 + ((n >> 4) & 3)) * nks + (k >> 5)) * 64 + ((k >> 3) & 3) * 16 + (n & 15)) * 8; }
template <int MODE  > __device__ __forceinline__ void p0_transpose_item(const float* W, int K, int N, bf16_t* WT, LAS float* scr, int item, int lane) {
    const int nblk = N / 32, kb = item / nblk, nb = item % nblk, k0 = 64 * kb, n0 = 32 * nb;
#pragma unroll 8
    for (int i = 0; i < 32; ++i) { const int kk = 2 * i + (lane >> 5); scr[kk * 33 + (lane & 31)] = W[(size_t)(k0 + kk) * N + n0 + (lane & 31)]; }
    asm volatile("s_waitcnt lgkmcnt(0)" ::: "memory");
    const int c = lane & 7;
#pragma unroll
    for (int j = 0; j < 4; ++j) { const int n = (lane >> 3) + 8 * j; const LAS float* s = scr + (8 * c) * 33 + n;
        u32x4 o; o.x = pk2(s[0 * 33], s[1 * 33]); o.y = pk2(s[2 * 33], s[3 * 33]); o.z = pk2(s[4 * 33], s[5 * 33]); o.w = pk2(s[6 * 33], s[7 * 33]);
        if (MODE == 2) *(u32x4*)(WT + frag_off(n0 + n, k0 + 8 * c, K / 32)) = o;
        else *(u32x4*)(WT + (size_t)(MODE == 1 ? win_dest_row(n0 + n) : n0 + n) * K + k0 + 8 * c) = o; }
    asm volatile("s_waitcnt lgkmcnt(0)" ::: "memory");
}

struct Args {
    const float* in[22]; float* out; unsigned char* ws; int ph_lo, ph_hi;
};

__device__ __forceinline__ void norm_row(const float* __restrict__ xsrc, const float* __restrict__ csrc, const float* __restrict__ g, const float* __restrict__ MODl, bf16_t* __restrict__ H, int row, int lane) {
    const int b = row / TPB, t = row % TPB; const bool isctx = t < CTX;
    const float* src = isctx ? csrc + ((size_t)b * CTX + t) * DM : xsrc + ((size_t)b * SEQ + (t - CTX)) * DM;
    const float* mod = MODl + (size_t)(isctx ? 4 : b) * N_MOD;
    f32x4 v[8]; float ss = 0.f;
#pragma unroll
    for (int j = 0; j < 8; ++j) { v[j] = ((const f32x4*)src)[lane + 64 * j]; ss += (v[j][0] * v[j][0] + v[j][1] * v[j][1]) + (v[j][2] * v[j][2] + v[j][3] * v[j][3]); }
    ss = wave_sum(ss);
    const float rstd = rsqrtf(ss * (1.f / DM) + EPS);
#pragma unroll
    for (int j = 0; j < 8; ++j) { const int col = (lane + 64 * j) * 4;
        const f32x4 gg = *(const f32x4*)(g + col), sh = *(const f32x4*)(mod + col), sc = *(const f32x4*)(mod + 2048 + col);
        const f32x4 o = v[j] * rstd * gg * (sc + 1.f) + sh;
        u32x2 w; w.x = pk2(o[0], o[1]); w.y = pk2(o[2], o[3]);
        *(u32x2*)(H + (size_t)row * DM + col) = w; }
}

__global__ void __launch_bounds__(NTHREADS, 2) mega_fwd(Args args) {
    extern __shared__ __attribute__((aligned(16))) unsigned char lds_raw[];
    LAS unsigned char* lds = (LAS unsigned char*)lds_raw;
    const int G = gridDim.x, bx = blockIdx.x; const int vcu = (G % 8 == 0) ? (bx % 8) * (G / 8) + bx / 8 : bx;
    unsigned char* ws = args.ws;
    unsigned* ctl = (unsigned*)(ws + WS_CTL);
    unsigned long long* g_ts = (unsigned long long*)(ws + WS_CTL + 32768); (void)g_ts;
    STAMP(0);
    const float* x = args.in[0]; const float* c_in = args.in[1]; const float* ctx = args.in[2]; const float* c_ctx = args.in[3];
    const float* w_mod = args.in[4]; const float* b_mod = args.in[5]; const float* norm_g = args.in[6]; const float* w_in = args.in[7];
    const float* subln_g = args.in[12]; const float* w_pool = args.in[13]; const float* pool_scale = args.in[14]; const float* w_dw = args.in[15];
    const float* b_dw = args.in[16]; const float* ln_g = args.in[17]; const float* ln_b = args.in[18]; const float* w_pw2 = args.in[19];
    const float* w_out = args.in[20]; const float* final_g = args.in[21];
    float* out = args.out;
    float* ROPE = (float*)(ws + WS_ROPE); float* MOD = (float*)(ws + WS_MOD);
    bf16_t* WIN = (bf16_t*)(ws + WS_WIN); bf16_t* WOUT = (bf16_t*)(ws + WS_WOUT); bf16_t* WPW2 = (bf16_t*)(ws + WS_WPW2); bf16_t* WPOOL = (bf16_t*)(ws + WS_WPOOL);
    float* CTXRES = (float*)(ws + WS_CTXRES); bf16_t* H = (bf16_t*)(ws + WS_H); bf16_t* P = (bf16_t*)(ws + WS_P); bf16_t* Y = (bf16_t*)(ws + WS_YMIX);

#if MK_USE_CG
    cg::grid_group grid = cg::this_grid();
#define SEAM() do { __syncthreads(); grid.sync(); } while (0)
#else
#if MK_COOP
    if (args.ph_lo < 0) cg::this_grid().sync();
#endif
    for (int u = threadIdx.x; u < (LDS_BYTES - LDSCTL_OFF) / 4; u += NTHREADS) ((LAS unsigned*)(lds + LDSCTL_OFF))[u] = 0u;
    __syncthreads();
    XcdBarrier bar = xcd_barrier_post(ctl + CW_BAR, (volatile LAS unsigned*)(lds + MISC_OFF) + 8);
#define SEAM() xcd_barrier(bar)
#endif
    const int lo = args.ph_lo, hi = args.ph_hi;
#define IN(k) (lo <= (k) && (k) < hi)
#define BOTH(k) (IN(k) && IN((k) + 1))
    const int NGW = G * NWAVES;
#define PHASE_IDS() const int tid = opaque_tid(), lane = tid & 63, wave = __builtin_amdgcn_readfirstlane(tid >> 6), gw = vcu * NWAVES + wave; (void)gw; (void)lane

    if (IN(0)) {
        PHASE_IDS();
        constexpr int N_MODITEMS = 2 * (N_MOD / 64);
        constexpr int I_WIN = (DM / 64) * (N_IN / 32), I_WOUT = (DM / 64) * (DM / 32), I_PW2 = (512 / 64) * (512 / 32), I_POOL = (128 / 64) * (128 / 32);
        constexpr int N_TR = 2 * I_WIN + 2 * I_WOUT + 2 * I_PW2 + 8 * I_POOL;
        constexpr int N_BITEMS = N_MODITEMS + 1 + (N_TR + 7) / 8;
        for (int rep = 0; rep < REP_P0; ++rep)
        for (int it = bx; it < N_BITEMS; it += G) {
            if (it < N_MODITEMS) {
                const int l = it / (N_MOD / 64), cgp = it % (N_MOD / 64);
                LAS float* s = (LAS float*)lds; LAS float* red = (LAS float*)(lds + 5 * 2048 * 4);
                for (int i = tid; i < 5 * 2048; i += NTHREADS) { const int r = i >> 11, k = i & 2047; const float v = r < 4 ? c_in[r * 2048 + k] : c_ctx[k]; s[i] = v / (1.f + expf(-v)); }
                __syncthreads();
                float acc[5] = {0.f, 0.f, 0.f, 0.f, 0.f};
                const float* W = w_mod + (size_t)l * DM * N_MOD + cgp * 64 + lane;
#pragma unroll 8
                for (int k = wave * 256; k < wave * 256 + 256; ++k) { const float w = W[(size_t)k * N_MOD];
#pragma unroll
                    for (int r = 0; r < 5; ++r) acc[r] += s[r * 2048 + k] * w; }
#pragma unroll
                for (int r = 0; r < 5; ++r) red[(wave * 5 + r) * 64 + lane] = acc[r];
                __syncthreads();
                if (tid < 320) { const int r = tid >> 6, ln = tid & 63; float v = b_mod[l * N_MOD + cgp * 64 + ln];
#pragma unroll
                    for (int w8 = 0; w8 < 8; ++w8) v += red[(w8 * 5 + r) * 64 + ln];
                    MOD[((size_t)l * 5 + r) * N_MOD + cgp * 64 + ln] = v; }
                __syncthreads();
            } else if (it == N_MODITEMS) {
                for (int i = tid; i < 64 * 16; i += NTHREADS) { const int pos = i >> 4, fi = i & 15; const float inv = powf(10000.f, -(float)fi / 16.f), ang = (float)pos * inv;
                    ROPE[i * 2] = cosf(ang); ROPE[i * 2 + 1] = sinf(ang); }
                if (tid < 2) { const int l = tid; float a = 0.f, b = 0.f;
                    for (int i = 0; i < 64; ++i) { a += args.in[8][l * 64 + i] * args.in[9][l * 64 + i]; b += args.in[10][l * 64 + i] * args.in[11][l * 64 + i]; }
                    const float lam_init = 0.8f - 0.6f * expf(-0.3f * (float)l);
                    MOD[2 * 5 * N_MOD + l] = expf(a) - expf(b) + lam_init; }
            } else {
                LAS float* scr = (LAS float*)(lds + wave * 16384);
                int r = (it - N_MODITEMS - 1) * 8 + wave;
                if (r < N_TR) {
                    if (r < 2 * I_WIN) { const int l = r / I_WIN; p0_transpose_item<1>(w_in + (size_t)l * DM * N_IN, DM, N_IN, WIN + (size_t)l * DM * N_IN, scr, r % I_WIN, lane); }
                    else if ((r -= 2 * I_WIN) < 2 * I_WOUT) { const int l = r / I_WOUT; p0_transpose_item<0>(w_out + (size_t)l * DM * DM, DM, DM, WOUT + (size_t)l * DM * DM, scr, r % I_WOUT, lane); }
                    else if ((r -= 2 * I_WOUT) < 2 * I_PW2) { const int l = r / I_PW2; p0_transpose_item<2>(w_pw2 + (size_t)l * 512 * 512, 512, 512, WPW2 + (size_t)l * 512 * 512, scr, r % I_PW2, lane); }
                    else { r -= 2 * I_PW2; const int lg = r / I_POOL; p0_transpose_item<2>(w_pool + (size_t)lg * 128 * 128, 128, 128, WPOOL + (size_t)lg * 128 * 128, scr, r % I_POOL, lane); }
                }
            }
        }
        STAMP(1);
        if (BOTH(0)) SEAM();
        STAMP(2);
    }

#pragma unroll 1
    for (int l = 0; l < DEPTH; ++l) {
        const float* MODl = MOD + (size_t)l * 5 * N_MOD;
        const float* xsrc = l == 0 ? x : out; const float* csrc = l == 0 ? ctx : CTXRES;
        const bool last = (l == DEPTH - 1);
        if (IN(1 + 4 * l)) {
            PHASE_IDS();
            STAMP(10 + 20 * l);
            for (int rep = 0; rep < REP_NORM; ++rep)
            for (int row = gw; row < M_TOT; row += NGW) norm_row(xsrc, csrc, norm_g + l * DM, MODl, H, row, lane);
            STAMP(11 + 20 * l);
            if (BOTH(1 + 4 * l)) SEAM();
            STAMP(12 + 20 * l);
        }
        if (IN(2 + 4 * l)) {
            pg8::Gemm g{H, WIN + (size_t)l * DM * N_IN, M_TOT, N_IN, DM};
            pg8::TileSched S; if (!last) S.init(36, N_IN / 256, 0, 0, G, bx); else S.init(32, N_IN / 256, 32, 1, G, bx);
            pg8::EpiIn E{P, ROPE};
            for (int rep = 0; rep < REP_INPROJ; ++rep)
            pg8::gemm_phase<pg8::EpiIn, pg8::TileSched, true, true>(lds, g, S, E);
            STAMP(13 + 20 * l);
            if (BOTH(2 + 4 * l)) SEAM();
            STAMP(14 + 20 * l);
        }
        if (IN(3 + 4 * l)) {
            const float lam = MOD[2 * 5 * N_MOD + l], lam_init = 0.8f - 0.6f * expf(-0.3f * (float)l), osc = 1.f - lam_init;
            { mixu::Args ma{P, Y, WPOOL + (size_t)l * 4 * 128 * 128, pool_scale + l * 512, w_dw + (size_t)l * 31 * 512, b_dw + l * 512, ln_g + l * 512, ln_b + l * 512, WPW2 + (size_t)l * 512 * 512};
              const int ntiles = last ? BATCH * SEQ / 32 : M_TOT / 32;
              for (int rep = 0; rep < REP_MIX; ++rep)
              for (int t = vcu; t < ntiles; t += G) { int row0;
                  if (last) row0 = (t / 64) * TPB + CTX + (t % 64) * 32; else row0 = t * 32;
                  mixu::mix_unit(ma, row0, lds, g_ts); } }
            STAMP(15 + 20 * l);
            { constexpr int NUL = BATCH * HEADS * (SEQ / 128), NUC = BATCH * HEADS * (CTX / 128); const int upc = (NUL + G - 1) / G, ncx = last ? 0 : (NUC + G - 1) / G;
              for (int rep = 0; rep < REP_ATT; ++rep)
              for (int i = 0; i < upc + ncx; ++i) {
                  int qrow0, krow0, nkeys, h;
                  if (i < upc) { const int id = vcu * upc + i; if (id >= NUL) continue;
                      const int bh = id / (SEQ / 128), qb = id % (SEQ / 128), b = bh / HEADS; h = bh % HEADS; qrow0 = b * TPB + CTX + qb * 128; krow0 = b * TPB; nkeys = TPB; }
                  else { const int id = vcu + (i - upc) * G; if (id >= NUC) continue;
                      const int bh = id / (CTX / 128), qb = id % (CTX / 128), b = bh / HEADS; h = bh % HEADS; qrow0 = b * TPB + qb * 128; krow0 = b * TPB; nkeys = CTX; }
                  att::attn_unit(P, Y, qrow0, krow0, nkeys, h, lam, osc, subln_g + l * 128, (char*)lds_raw, g_ts); } }
            STAMP(16 + 20 * l);
            if (BOTH(3 + 4 * l)) SEAM();
            STAMP(17 + 20 * l);
        }
        if (IN(4 + 4 * l)) {
            pg8::Gemm g{Y, WOUT + (size_t)l * DM * DM, M_TOT, DM, DM};
            pg8::TileSched S; if (!last) S.init(36, DM / 256, 0, 0, G, bx); else S.init(32, DM / 256, 0, 1, G, bx);
            pg8::EpiOut E{xsrc, csrc, out, CTXRES, MODl};
            for (int rep = 0; rep < (last ? 1 : REP_OUT); ++rep)
            pg8::gemm_phase<pg8::EpiOut, pg8::TileSched, true, true>(lds, g, S, E);
            STAMP(18 + 20 * l);
            if (BOTH(4 + 4 * l)) SEAM();
            STAMP(19 + 20 * l);
        }
    }
    if (IN(9)) {
        PHASE_IDS();
        for (int row = gw; row < BATCH * SEQ; row += NGW) {
            f32x4* p = (f32x4*)(out + (size_t)row * DM); f32x4 v[8]; float ss = 0.f;
#pragma unroll
            for (int j = 0; j < 8; ++j) { v[j] = p[lane + 64 * j]; ss += (v[j][0] * v[j][0] + v[j][1] * v[j][1]) + (v[j][2] * v[j][2] + v[j][3] * v[j][3]); }
            const float rstd = rsqrtf(wave_sum(ss) * (1.f / DM) + EPS);
#pragma unroll
            for (int j = 0; j < 8; ++j) { const f32x4 gg = *(const f32x4*)(final_g + (lane + 64 * j) * 4); p[lane + 64 * j] = v[j] * rstd * gg; }
        }
    }
#if MK_PROBE
    STAMP(50);
    if (blockIdx.x == 0 && threadIdx.x == 0) { const unsigned long long dt = (g_ts[PROBE_X1] - g_ts[PROBE_X0]) * PROBE_AMP, t0 = __builtin_amdgcn_s_memrealtime();
        while (__builtin_amdgcn_s_memrealtime() - t0 < dt) __builtin_amdgcn_s_sleep(8); }
#endif
#undef IN
#undef BOTH
#undef SEAM
}

extern "C" void kernel_launch(void* const* d_in, const int* in_sizes, int n_in, void* d_out, int out_size, void* d_ws, size_t ws_size, hipStream_t stream) {
    static int grid = 0;
    if (grid == 0) {
        if (n_in != 22 || ws_size < WS_END || out_size != BATCH * SEQ * DM) { fprintf(stderr, "kernel_launch: unexpected n_in %d / out %d / ws %zu\n", n_in, out_size, ws_size); grid = -1; return; }
        int dev = 0, cus = 0, per_cu = 0;
        if (hipGetDevice(&dev) != hipSuccess || hipDeviceGetAttribute(&cus, hipDeviceAttributeMultiprocessorCount, dev) != hipSuccess) { grid = -1; return; }
        if (hipFuncSetAttribute((const void*)mega_fwd, hipFuncAttributeMaxDynamicSharedMemorySize, LDS_BYTES) != hipSuccess) { fprintf(stderr, "kernel_launch: hipFuncSetAttribute failed\n"); grid = -1; return; }
        if (hipOccupancyMaxActiveBlocksPerMultiprocessor(&per_cu, (const void*)mega_fwd, NTHREADS, LDS_BYTES) != hipSuccess || per_cu < 1) { fprintf(stderr, "kernel_launch: occupancy query says %d blocks per CU\n", per_cu); grid = -1; return; }
        (void)hipGetLastError();
        grid = cus;
    }
    if (grid < 0) return;
    (void)hipMemsetAsync((char*)d_ws + WS_CTL, 0, CTL_ZERO_BYTES, stream);
    Args a{};
    for (int i = 0; i < 22; ++i) a.in[i] = (const float*)d_in[i];
    a.out = (float*)d_out; a.ws = (unsigned char*)d_ws;
#if MK_PER_PHASE
    for (int ph = 0; ph < 10; ++ph) { a.ph_lo = ph; a.ph_hi = ph + 1;
        void* kargs[] = {&a};
        hipError_t e = hipLaunchCooperativeKernel((void*)mega_fwd, dim3(grid), dim3(NTHREADS), kargs, LDS_BYTES, stream);
        if (e != hipSuccess) { fprintf(stderr, "kernel_launch: launch failed: %s\n", hipGetErrorString(e)); break; } }
#else
    a.ph_lo = 0; a.ph_hi = 10;
#if MK_COOP
    void* kargs[] = {&a};
    hipError_t e = hipLaunchCooperativeKernel((void*)mega_fwd, dim3(grid), dim3(NTHREADS), kargs, LDS_BYTES, stream);
#else
    hipLaunchKernelGGL(mega_fwd, dim3(grid), dim3(NTHREADS), LDS_BYTES, stream, a);
    hipError_t e = hipPeekAtLastError();
#endif
    if (e != hipSuccess) fprintf(stderr, "kernel_launch: launch failed: %s (grid %d)\n", hipGetErrorString(e), grid);
#endif
}
```

```cpp
#include <hip/hip_runtime.h>
#include <hip/hip_cooperative_groups.h>
#include <cstdint>
#include <cstdio>
#include <cmath>
namespace cg = cooperative_groups;

#ifndef MK_USE_CG
#define MK_USE_CG 0
#endif
#ifndef REP_P0
#define REP_P0 1
#endif
#ifndef DEFER_R1
#define DEFER_R1 1
#endif
#ifndef DEFER_R2
#define DEFER_R2 1
#endif
#ifndef REP_P0M
#define REP_P0M 1
#endif
#ifndef REP_P0T
#define REP_P0T 1
#endif
#ifndef REP_NORM
#define REP_NORM 1
#endif
#ifndef REP_INPROJ
#define REP_INPROJ 1
#endif
#ifndef REP_MIX
#define REP_MIX 1
#endif
#ifndef REP_ATT
#define REP_ATT 1
#endif
#ifndef REP_OUT
#define REP_OUT 1
#endif
#ifndef REP_MX_POOL
#define REP_MX_POOL 1
#endif
#ifndef REP_MX_GLU
#define REP_MX_GLU 1
#endif
#ifndef REP_MX_CONV
#define REP_MX_CONV 1
#endif
#ifndef REP_MX_LN
#define REP_MX_LN 1
#endif
#ifndef REP_MX_PW2
#define REP_MX_PW2 1
#endif
#ifndef MK_PROBE
#define MK_PROBE 0
#endif
#define PROBE_X0 14
#define PROBE_X1 15
#define PROBE_Y0 15
#define PROBE_Y1 16
#define PROBE_AMP 8
#if MK_PROBE
#define STAMP(k) do { if (blockIdx.x == 0 && wv0 == 0 && lane_id() == 0) { g_ts[(k)] = __builtin_amdgcn_s_memrealtime(); } } while (0)
#else
#define STAMP(k) do { } while (0)
#endif
#if MK_PROBE == 2
#define STAMPI(k) STAMP(k)
#else
#define STAMPI(k) do { } while (0)
#endif
#ifndef MK_COOP
#define MK_COOP 0
#endif
#ifndef MK_PER_PHASE
#define MK_PER_PHASE 0
#endif

constexpr int DM = 2048, BATCH = 4, SEQ = 2048, DEPTH = 2, CTX = 256;
constexpr int N_IN = 6656, N_MOD = 6144, HEADS = 8;
constexpr int TPB = CTX + SEQ;
constexpr int M_TOT = BATCH * TPB;
constexpr float EPS = 1e-6f;
constexpr int C_Q = 0, C_K = 1024, C_V = 2048, C_GA = 3072, C_UP = 4096, C_GP = 4608, C_CA = 5120, C_CB = 5632, C_GC = 6144;
constexpr int NWAVES = 8, NTHREADS = 512;

#define LAS __attribute__((address_space(3)))
#define GAS __attribute__((address_space(1)))
typedef unsigned short bf16_t;
typedef short bf16x8 __attribute__((ext_vector_type(8)));
typedef short s16x4 __attribute__((ext_vector_type(4)));
typedef float f32x4 __attribute__((ext_vector_type(4)));
typedef float f32x16 __attribute__((ext_vector_type(16)));
typedef unsigned u32x4 __attribute__((ext_vector_type(4)));
typedef unsigned u32x2 __attribute__((ext_vector_type(2)));

__device__ __forceinline__ float bf2f(bf16_t v) { return __uint_as_float(((unsigned)v) << 16); }
__device__ __forceinline__ unsigned f2bf(float f) { unsigned u = __float_as_uint(f); return (u + 0x7fffu + ((u >> 16) & 1u)) >> 16; }
__device__ __forceinline__ unsigned pk2(float lo, float hi) { return f2bf(lo) | (f2bf(hi) << 16); }
__device__ __forceinline__ unsigned cvt_pk_bf16(float lo, float hi) { unsigned r; asm volatile("v_cvt_pk_bf16_f32 %0, %1, %2" : "=v"(r) : "v"(lo), "v"(hi)); return r; }
__device__ __forceinline__ float silu_f(float v) { return v * __builtin_amdgcn_rcpf(1.f + __expf(-v)); }
__device__ __forceinline__ float sigm_f(float v) { return __builtin_amdgcn_rcpf(1.f + __expf(-v)); }
__device__ __forceinline__ float wave_sum(float v) {
#pragma unroll
    for (int o = 1; o < 64; o <<= 1) v += __shfl_xor(v, o);
    return v;
}

__device__ __forceinline__ int lane_id() { int t; asm volatile("v_mbcnt_lo_u32_b32 %0, -1, 0\n\tv_mbcnt_hi_u32_b32 %0, -1, %0" : "=v"(t)); return t; }
__device__ __forceinline__ int opaque_tid(int wv0) { return wv0 * 64 + lane_id(); }

constexpr size_t MiB = 1u << 20;
constexpr size_t WS_CTL = 0, CTL_ZERO_BYTES = 64 * 1024 + 2 * 5 * 6144 * 4;
constexpr size_t WS_ROPE = 512 * 1024;
constexpr size_t WS_MOD = 64 * 1024;
constexpr size_t WS_WIN = 2 * MiB;
constexpr size_t WS_WOUT = 54 * MiB;
constexpr size_t WS_WPW2 = 70 * MiB;
constexpr size_t WS_WPOOL = 71 * MiB;
constexpr size_t WS_CTXRES = 72 * MiB;
constexpr size_t WS_H = 80 * MiB;
constexpr size_t WS_P = 116 * MiB;
constexpr size_t WS_YMIX = 234 * MiB;
constexpr size_t WS_CTXS = 270 * MiB;
constexpr size_t WS_END = 302 * MiB;
constexpr int CW_BAR = 1024;
constexpr int CW_STEAL = 512;

constexpr int RING_BYTES = 131072;
constexpr int LDSCTL_OFF = RING_BYTES, MISC_OFF = LDSCTL_OFF + 320;
constexpr int LDS_BYTES = 147456;

namespace pg8 {
constexpr int BM = 256, BK = 64, HALF = 128, HTB = HALF * BK * 2, STAGE_BYTES = 8 * HTB, NXCD = 8, WGM = 8;
__host__ __device__ __forceinline__ int lds_byte(int r, int c) { const int st = (r >> 4) * 2 + (c >> 5), rr = r & 15, cc = c & 31, ob = rr * 64 + cc * 2; return st * 1024 + (ob ^ (((ob >> 9) & 1) << 5)); }
__host__ __device__ __forceinline__ void stage_rc(int b, int& R, int& C) { const int st = b / 1024, sb = b % 1024, swz = sb ^ (((sb >> 9) & 1) << 5); R = (st >> 1) * 16 + swz / 64; C = (st & 1) * 32 + (swz % 64) / 2; }
__host__ __device__ __forceinline__ int perm32(int rho) { const int n = rho >> 4, i = rho & 15; return 8 * (i >> 2) + 4 * n + (i & 3); }

struct Unit { int pm, pn, ks; };
struct Gemm { const bf16_t* A; const bf16_t* Bt; int M, N, K, ld; };

struct TileSched {
    int nM, nN, nreg, nwg, G, c, lat_only, slices;
    __device__ void init(int nM_, int nN_, int nextra, int lat_only_, int G_, int c_, int slices_ = 0) { nM = nM_; nN = nN_; nreg = nM_ * nN_; nwg = nreg + nextra; lat_only = lat_only_; G = G_; c = c_; slices = slices_; }
    __device__ bool next(int i, Unit& u) const {
        const long L = (long)i * G + c; if (L >= nwg) return false;
        int wgid = (int)L; { const int q = nwg / NXCD, r = nwg % NXCD, xcd = wgid % NXCD, off = wgid / NXCD; wgid = (xcd < r ? xcd * (q + 1) : r * (q + 1) + (xcd - r) * q) + off; }
        if (wgid < nreg) {
            const int nig = WGM * nN, gid = wgid / nig, fm = gid * WGM, gsz = (nM - fm) < WGM ? (nM - fm) : WGM;
            const int j = fm + ((wgid % nig) % gsz); u.pn = (wgid % nig) / gsz;
            u.pm = lat_only ? (j >> 3) * 9 + 1 + (j & 7) : j;
            u.ks = 0;
        } else if (slices) { const int e = wgid - nreg; u.pm = (e >> 5) * 9; u.pn = (e >> 2) & 7; u.ks = e & 3; }
        else { const int e = wgid - nreg; u.pm = (e >> 3) * 9; u.pn = 4 + (e & 7); u.ks = 0; }
        return true;
    }
    __device__ __forceinline__ void a_ready(const Unit&) const {}
    __device__ __forceinline__ void done(const Unit&) const {}
};

struct EpiIn {
    static constexpr bool PERM = false, AFTER_DRAIN = false;
    bf16_t* P; const float* rope;
    __device__ __forceinline__ void operator()(const f32x4 (&acc)[2][2][4][2], const Unit& u, int wr, int wc, int fr, int fq) const {
        const int bt = u.pm % 9; const bool do_rope = (u.pn < 8) && (bt != 0), glu = (u.pn >= 20) && (u.pn < 24);
        const int col0 = u.pn * BM + wc * 32 + 4 * fq;
#pragma unroll
        for (int ai = 0; ai < 2; ++ai)
#pragma unroll
            for (int m = 0; m < 4; ++m) {
                const int rl = ai * HALF + wr * 64 + m * 16 + fr; const size_t row = (size_t)u.pm * BM + rl;
                f32x4 cs = {1.f, 1.f, 1.f, 1.f}, sn = {0.f, 0.f, 0.f, 0.f};
                if (do_rope) { const int tl = (bt - 1) * 256 + rl, pos = (wc & 1) ? (tl & 63) : (tl >> 6);
                    const f32x4 a = *(const f32x4*)(rope + (pos * 16 + 4 * fq) * 2), b = *(const f32x4*)(rope + (pos * 16 + 4 * fq) * 2 + 4);
                    cs = (f32x4){a[0], a[2], b[0], b[2]}; sn = (f32x4){a[1], a[3], b[1], b[3]}; }
                bf16_t* rowp = P + row * N_IN + col0;
                if (glu) {
#pragma unroll
                    for (int bj = 0; bj < 2; ++bj) { const f32x4 v0 = acc[ai][bj][m][0], v1 = acc[ai][bj][m][1]; const int g32 = (u.pn - 20) * 8 + bj * 4 + wc;
                        u32x2 w0; w0.x = cvt_pk_bf16(v0[0] * sigm_f(v1[0]), v0[1] * sigm_f(v1[1])); w0.y = cvt_pk_bf16(v0[2] * sigm_f(v1[2]), v0[3] * sigm_f(v1[3]));
                        *(u32x2*)(P + row * N_IN + C_CA + g32 * 16 + 4 * fq) = w0; }
                } else {
#pragma unroll
                for (int bj = 0; bj < 2; ++bj) { const f32x4 v0 = acc[ai][bj][m][0], v1 = acc[ai][bj][m][1];
                    const f32x4 o0 = v0 * cs - v1 * sn, o1 = v1 * cs + v0 * sn;
                    u32x2 w0, w1; w0.x = cvt_pk_bf16(o0[0], o0[1]); w0.y = cvt_pk_bf16(o0[2], o0[3]); w1.x = cvt_pk_bf16(o1[0], o1[1]); w1.y = cvt_pk_bf16(o1[2], o1[3]);
                    *(u32x2*)(rowp + bj * HALF) = w0; *(u32x2*)(rowp + bj * HALF + 16) = w1; }
                }
            }
    }
};
struct EpiOut {
    static constexpr bool PERM = false, AFTER_DRAIN = false;
    const float* xin; const float* cin; float* xout; float* cout; const float* MODl;
    __device__ __forceinline__ void operator()(const f32x4 (&acc)[2][2][4][2], const Unit& u, int wr, int wc, int fr, int fq) const {
        const int bt = u.pm % 9, b = u.pm / 9; const bool lat = bt != 0;
        const int col0 = u.pn * BM + wc * 32 + 4 * fq;
        const float* gp = MODl + (size_t)(lat ? b : 4) * N_MOD + 4096 + col0;
        f32x4 gv[2][2];
#pragma unroll
        for (int bj = 0; bj < 2; ++bj)
#pragma unroll
            for (int n = 0; n < 2; ++n) gv[bj][n] = *(const f32x4*)(gp + bj * HALF + n * 16);
        const float* src = lat ? xin : cin; float* dst = lat ? xout : cout + (size_t)u.ks * (BATCH * CTX * DM); const bool addres = lat || u.ks == 0;
#pragma unroll
        for (int ai = 0; ai < 2; ++ai)
#pragma unroll
            for (int m = 0; m < 4; ++m) {
                const int rl = ai * HALF + wr * 64 + m * 16 + fr;
                const size_t off = (lat ? ((size_t)b * SEQ + (bt - 1) * 256 + rl) : ((size_t)b * CTX + rl)) * DM + col0;
#pragma unroll
                for (int bj = 0; bj < 2; ++bj)
#pragma unroll
                    for (int n = 0; n < 2; ++n) { f32x4 o = gv[bj][n] * acc[ai][bj][m][n]; if (addres) o += *(const f32x4*)(src + off + bj * HALF + n * 16); *(f32x4*)(dst + off + bj * HALF + n * 16) = o; }
            }
    }
};

template <class Epi, class Sched, bool ALIGN_EPI = false, bool SP2 = false>
__device__ __forceinline__ void gemm_phase(LAS unsigned char* lds, const Gemm g, const Sched& S, const Epi& E, int wv0) {
    const int tid = opaque_tid(wv0), wid = __builtin_amdgcn_readfirstlane(tid >> 6), lane = tid & 63, wr = wid >> 2, wc = wid & 3, fr = lane & 15, fq = lane >> 4;
    const int K = g.ld, nt = g.K / BK;
    unsigned voffA[2], voffB[2];
#pragma unroll
    for (int i = 0; i < 2; ++i) { int R, C; stage_rc(tid * 16 + i * 8192, R, C); const int Rb = Epi::PERM ? ((R & ~31) + perm32(R & 31)) : R;
        voffA[i] = (unsigned)(R * K + C) * 2u; voffB[i] = (unsigned)(Rb * K + C) * 2u; }
    const size_t kstep = (size_t)(BK * 2);
    const size_t hstep = (size_t)HALF * K * 2;
    const size_t tstep = 2 * hstep;
    const unsigned ldsw = (unsigned)wid * 1024u;
    const int aoff = lds_byte(wr * 64 + fr, fq * 8), boff = lds_byte(wc * 32 + fr, fq * 8);
#define PG8_SA(b, h) (((b) * 2 + (h)) * HTB)
#define PG8_SB(b, h) ((4 + (b) * 2 + (h)) * HTB)
#define PG8_STAGE(bufoff, gbase, voff) do { _Pragma("unroll") for (int _i = 0; _i < 2; ++_i) \
        __builtin_amdgcn_global_load_lds((const unsigned*)((const char*)(gbase) + (voff)[_i]), (LAS unsigned*)(lds + (bufoff) + ldsw + _i * 8192), 16, 0, 0); } while (0)
#define PG8_LDA(dst, b, h) do { _Pragma("unroll") for (int m = 0; m < 4; ++m) _Pragma("unroll") for (int k = 0; k < 2; ++k) dst[m][k] = *(const LAS bf16x8*)(lds + PG8_SA(b, h) + aoff + m * 2048 + k * 1024); } while (0)
#define PG8_LDB(dst, b, h) do { _Pragma("unroll") for (int n = 0; n < 2; ++n) _Pragma("unroll") for (int k = 0; k < 2; ++k) dst[n][k] = *(const LAS bf16x8*)(lds + PG8_SB(b, h) + boff + n * 2048 + k * 1024); } while (0)
#define PG8_MMA(ai, bj, At, Bt) do { __builtin_amdgcn_s_setprio(1); _Pragma("unroll") for (int m = 0; m < 4; ++m) _Pragma("unroll") for (int n = 0; n < 2; ++n) _Pragma("unroll") for (int k = 0; k < 2; ++k) \
        acc[ai][bj][m][n] = __builtin_amdgcn_mfma_f32_16x16x32_bf16(Bt[n][k], At[m][k], acc[ai][bj][m][n], 0, 0, 0); __builtin_amdgcn_s_setprio(0); } while (0)
#define PG8_WAIT_V(n) asm volatile("s_waitcnt vmcnt(" #n ")" ::: "memory")
#define PG8_WAIT_L(n) asm volatile("s_waitcnt lgkmcnt(" #n ")" ::: "memory")
#define PG8_BAR __builtin_amdgcn_s_barrier()
#define PG8_SCHED __builtin_amdgcn_sched_barrier(0)
    Unit cur, nxt; int ui = 0;
    if (!S.next(0, cur)) return;
    f32x4 acc[2][2][4][2];
#pragma unroll
    for (int a = 0; a < 2; ++a)
#pragma unroll
        for (int b = 0; b < 2; ++b)
#pragma unroll
            for (int m = 0; m < 4; ++m)
#pragma unroll
                for (int n = 0; n < 2; ++n) acc[a][b][m][n] = (f32x4){0.f, 0.f, 0.f, 0.f};
    bf16x8 At[4][2], B0[2][2], B1[2][2];
    const size_t sstep = (size_t)g.K * 2;
    const char* cA = (const char*)g.A + (size_t)cur.pm * tstep + cur.ks * sstep; const char* cB = (const char*)g.Bt + (size_t)cur.pn * tstep + cur.ks * sstep;
    S.a_ready(cur);
    if constexpr (SP2) {
        PG8_STAGE(PG8_SB(0, 0), cB, voffB); PG8_STAGE(PG8_SB(0, 1), cB + hstep, voffB); PG8_STAGE(PG8_SA(0, 0), cA, voffA); PG8_STAGE(PG8_SA(0, 1), cA + hstep, voffA);
        if (wr == 1) PG8_BAR;
        PG8_WAIT_V(2); PG8_BAR;
        PG8_STAGE(PG8_SB(1, 0), cB + kstep, voffB); PG8_STAGE(PG8_SA(1, 0), cA + kstep, voffA); PG8_STAGE(PG8_SB(1, 1), cB + hstep + kstep, voffB);
        PG8_WAIT_V(6); PG8_BAR;
    } else {
        PG8_STAGE(PG8_SB(0, 0), cB, voffB); PG8_STAGE(PG8_SA(0, 0), cA, voffA); PG8_STAGE(PG8_SB(0, 1), cB + hstep, voffB); PG8_STAGE(PG8_SA(0, 1), cA + hstep, voffA);
        if (wr == 1) PG8_BAR;
        PG8_WAIT_V(4); PG8_BAR;
        PG8_STAGE(PG8_SB(1, 0), cB + kstep, voffB); PG8_STAGE(PG8_SA(1, 0), cA + kstep, voffA); PG8_STAGE(PG8_SB(1, 1), cB + hstep + kstep, voffB);
        PG8_WAIT_V(6); PG8_BAR;
    }
    for (;;) {
        const bool has_next = S.next(ui + 1, nxt);
        const char* nA = has_next ? (const char*)g.A + (size_t)nxt.pm * tstep + nxt.ks * sstep : cA; const char* nB = has_next ? (const char*)g.Bt + (size_t)nxt.pn * tstep + nxt.ks * sstep : cB;
        for (int t = 0; t < nt; t += 2) {
            const bool last = (t == nt - 2);
            const char* a1 = cA + (size_t)(t + 1) * kstep;
            const char* a2 = last ? nA : cA + (size_t)(t + 2) * kstep; const char* b2 = last ? nB : cB + (size_t)(t + 2) * kstep;
            const char* a3 = a2 + kstep; const char* b3 = b2 + kstep;
            if (last && has_next) S.a_ready(nxt);
            if constexpr (SP2) {
            PG8_LDB(B0, 0, 0); PG8_LDB(B1, 0, 1); PG8_SCHED; PG8_LDA(At, 0, 0); PG8_STAGE(PG8_SA(1, 1), a1 + hstep, voffA);
            PG8_WAIT_V(8); PG8_WAIT_L(0); PG8_BAR; PG8_MMA(0, 0, At, B0); PG8_MMA(0, 1, At, B1); PG8_BAR; PG8_SCHED;
            PG8_LDA(At, 0, 1); PG8_STAGE(PG8_SB(0, 0), b2, voffB); PG8_STAGE(PG8_SB(0, 1), b2 + hstep, voffB); PG8_STAGE(PG8_SA(0, 0), a2, voffA);
            PG8_WAIT_V(8); PG8_WAIT_L(0); PG8_BAR; PG8_MMA(1, 0, At, B0); PG8_MMA(1, 1, At, B1); PG8_BAR; PG8_SCHED;
            PG8_LDB(B0, 1, 0); PG8_LDB(B1, 1, 1); PG8_SCHED; PG8_LDA(At, 1, 0); PG8_STAGE(PG8_SA(0, 1), a2 + hstep, voffA);
            PG8_WAIT_V(8); PG8_WAIT_L(0); PG8_BAR; PG8_MMA(0, 0, At, B0); PG8_MMA(0, 1, At, B1); PG8_BAR; PG8_SCHED;
            PG8_LDA(At, 1, 1); PG8_STAGE(PG8_SB(1, 0), b3, voffB); PG8_STAGE(PG8_SB(1, 1), b3 + hstep, voffB); PG8_STAGE(PG8_SA(1, 0), a3, voffA);
            PG8_WAIT_V(8); PG8_WAIT_L(0); PG8_BAR; PG8_MMA(1, 0, At, B0); PG8_MMA(1, 1, At, B1); PG8_BAR; PG8_SCHED;
            } else {
            PG8_LDB(B0, 0, 0); PG8_SCHED; PG8_LDA(At, 0, 0); PG8_STAGE(PG8_SA(1, 1), a1 + hstep, voffA);
            PG8_WAIT_L(8); PG8_BAR; PG8_WAIT_L(0); PG8_MMA(0, 0, At, B0); PG8_BAR; PG8_SCHED;
            PG8_LDB(B1, 0, 1); PG8_STAGE(PG8_SB(0, 0), b2, voffB);
            PG8_BAR; PG8_WAIT_L(0); PG8_MMA(0, 1, At, B1); PG8_BAR;
            PG8_LDA(At, 0, 1); PG8_STAGE(PG8_SA(0, 0), a2, voffA);
            PG8_BAR; PG8_WAIT_L(0); PG8_MMA(1, 0, At, B0); PG8_BAR; PG8_SCHED;
            PG8_STAGE(PG8_SB(0, 1), b2 + hstep, voffB);
            PG8_WAIT_V(6); PG8_BAR; PG8_MMA(1, 1, At, B1); PG8_BAR;
            PG8_LDB(B0, 1, 0); PG8_SCHED; PG8_LDA(At, 1, 0); PG8_STAGE(PG8_SA(0, 1), a2 + hstep, voffA);
            PG8_WAIT_L(8); PG8_BAR; PG8_WAIT_L(0); PG8_MMA(0, 0, At, B0); PG8_BAR; PG8_SCHED;
            PG8_LDB(B1, 1, 1); PG8_STAGE(PG8_SB(1, 0), b3, voffB);
            PG8_BAR; PG8_WAIT_L(0); PG8_MMA(0, 1, At, B1); PG8_BAR;
            PG8_LDA(At, 1, 1); PG8_STAGE(PG8_SA(1, 0), a3, voffA);
            PG8_BAR; PG8_WAIT_L(0); PG8_MMA(1, 0, At, B0); PG8_BAR; PG8_SCHED;
            PG8_STAGE(PG8_SB(1, 1), b3 + hstep, voffB);
            PG8_WAIT_V(6); PG8_BAR; PG8_MMA(1, 1, At, B1); PG8_BAR;
            }
        }
        if constexpr (ALIGN_EPI) { if (wr == 0) PG8_BAR; }
        if constexpr (!Epi::AFTER_DRAIN) { E(acc, cur, wr, wc, fr, fq); S.done(cur); }
        if (!has_next) break;
#pragma unroll
        for (int a = 0; a < 2; ++a)
#pragma unroll
            for (int b = 0; b < 2; ++b)
#pragma unroll
                for (int m = 0; m < 4; ++m)
#pragma unroll
                    for (int n = 0; n < 2; ++n) acc[a][b][m][n] = (f32x4){0.f, 0.f, 0.f, 0.f};
        cur = nxt; cA = nA; cB = nB; ++ui;
        if constexpr (ALIGN_EPI) { if (wr == 1) PG8_BAR; }
    }
    PG8_WAIT_V(0);
    if constexpr (!ALIGN_EPI) { if (wr == 0) PG8_BAR; }
    PG8_BAR;
#undef PG8_SA
#undef PG8_SB
#undef PG8_STAGE
#undef PG8_LDA
#undef PG8_LDB
#undef PG8_MMA
#undef PG8_WAIT_V
#undef PG8_WAIT_L
#undef PG8_BAR
#undef PG8_SCHED
}
}

namespace att {
constexpr int KVBLK = 64;
constexpr int SHM_V = KVBLK * 128 * 2, SHM_K = KVBLK * 128 * 2;
constexpr int OFF_V = 0, OFF_K = 2 * SHM_V, OFF_WS = 2 * SHM_V + 2 * SHM_K, ATT_LDS = OFF_WS + NWAVES * 64 * 4;
constexpr float SCALE = 0.125f, THR = 8.f;
#define KSWZ(row, colB) ((row) * 256 + ((colB) ^ (((row) & 7) << 4)))
#define SBAR() __builtin_amdgcn_sched_barrier(0)
__device__ __forceinline__ int crow(int r, int hi) { return (r & 3) + 8 * (r >> 2) + 4 * hi; }
__device__ __forceinline__ void partialSM(f32x16& p0, f32x16& p1, float& m_reg, float& mn, float& alpha) {
    constexpr float C = SCALE * 1.4426950408889634f;
    float pmax = p0[0];
#pragma unroll
    for (int r = 1; r < 16; ++r) pmax = fmaxf(pmax, p0[r]);
#pragma unroll
    for (int r = 0; r < 16; ++r) pmax = fmaxf(pmax, p1[r]);
    { auto rr = __builtin_amdgcn_permlane32_swap(__float_as_uint(pmax), __float_as_uint(pmax), false, false);
      pmax = fmaxf(__uint_as_float(rr[0]), __uint_as_float(rr[1])); }
    if (__builtin_expect(__all(pmax - m_reg <= THR / SCALE), 1)) { mn = m_reg; alpha = 1.f; }
    else { mn = fmaxf(m_reg, pmax); alpha = __builtin_amdgcn_exp2f((m_reg - mn) * C); m_reg = mn; }
    const float mnC = -mn * C;
#pragma unroll
    for (int r = 0; r < 16; ++r) p0[r] = fmaf(p0[r], C, mnC);
#pragma unroll
    for (int r = 0; r < 16; ++r) p1[r] = fmaf(p1[r], C, mnC);
#pragma unroll
    for (int r = 0; r < 16; ++r) p0[r] = __builtin_amdgcn_exp2f(p0[r]);
}
__device__ __forceinline__ void finishSM(f32x16& p0, f32x16& p1, float alpha, float& l_reg, bf16x8& pa0, bf16x8& pa1, bf16x8& pa2, bf16x8& pa3) {
#pragma unroll
    for (int r = 0; r < 16; ++r) p1[r] = __builtin_amdgcn_exp2f(p1[r]);
    float ps = 0;
#pragma unroll
    for (int r = 0; r < 16; ++r) ps += p0[r];
#pragma unroll
    for (int r = 0; r < 16; ++r) ps += p1[r];
    { auto rr = __builtin_amdgcn_permlane32_swap(__float_as_uint(ps), __float_as_uint(ps), false, false);
      ps = __uint_as_float(rr[0]) + __uint_as_float(rr[1]); }
    l_reg = l_reg * alpha + ps;
#define PK4(P, BASE, OUT) do { unsigned a0 = cvt_pk_bf16(P[BASE + 0], P[BASE + 1]), a1 = cvt_pk_bf16(P[BASE + 2], P[BASE + 3]);   \
    unsigned b0 = cvt_pk_bf16(P[BASE + 4], P[BASE + 5]), b1 = cvt_pk_bf16(P[BASE + 6], P[BASE + 7]);                              \
    auto r0 = __builtin_amdgcn_permlane32_swap(a0, b0, false, false); auto r1 = __builtin_amdgcn_permlane32_swap(a1, b1, false, false); \
    u32x4 w = {r0[0], r1[0], r0[1], r1[1]}; OUT = *reinterpret_cast<bf16x8*>(&w); } while (0)
    PK4(p0, 0, pa0); PK4(p0, 8, pa1); PK4(p1, 0, pa2); PK4(p1, 8, pa3);
#undef PK4
}
__device__ __forceinline__ void qkt(f32x16& p0, f32x16& p1, const char* Ks, const bf16x8* qr, int r32, int hi, int cbase) {
    p0 = f32x16{}; p1 = f32x16{};
#pragma unroll
    for (int d0 = 0; d0 < 4; ++d0) { const int cb = cbase + (d0 * 16 + hi * 8) * 2;
        const bf16x8 b0 = *reinterpret_cast<const bf16x8*>(Ks + KSWZ(r32, cb));
        const bf16x8 b1 = *reinterpret_cast<const bf16x8*>(Ks + KSWZ(32 + r32, cb));
        p0 = __builtin_amdgcn_mfma_f32_32x32x16_bf16(b0, qr[d0], p0, 0, 0, 0);
        p1 = __builtin_amdgcn_mfma_f32_32x32x16_bf16(b1, qr[d0], p1, 0, 0, 0); }
}
__device__ __forceinline__ int v_st(int k, int c) { const int kk = (k & ~0xC) | ((k & 4) << 1) | ((k & 8) >> 1); return ((kk >> 3) * 4 + (c >> 5)) * 512 + ((kk & 7) * 32 + (c & 31)) * 2; }
__device__ __forceinline__ int v_rd_base(int lane) { return ((lane & 3) << 3) | (((lane >> 2) & 3) << 6) | (((lane >> 4) & 1) << 5) | (((lane >> 5) & 1) << 8); }
constexpr int v_rd_off(int d0, int ks, int half) { return d0 * 512 + ks * 4096 + half * 2048; }
template <int OFF> __device__ __forceinline__ s16x4 tr_read(int vb) {
    s16x4 r; asm volatile("ds_read_b64_tr_b16 %0, %1 offset:%2" : "=&v"(r) : "v"(vb), "i"(OFF) : "memory"); return r;
}
template <int D0> __device__ __forceinline__ void pv_one(f32x16& od, int vb, bf16x8 pa0, bf16x8 pa1, bf16x8 pa2, bf16x8 pa3) {
    const s16x4 l0 = tr_read<v_rd_off(D0, 0, 0)>(vb), h0 = tr_read<v_rd_off(D0, 0, 1)>(vb), l1 = tr_read<v_rd_off(D0, 1, 0)>(vb), h1 = tr_read<v_rd_off(D0, 1, 1)>(vb);
    const s16x4 l2 = tr_read<v_rd_off(D0, 2, 0)>(vb), h2 = tr_read<v_rd_off(D0, 2, 1)>(vb), l3 = tr_read<v_rd_off(D0, 3, 0)>(vb), h3 = tr_read<v_rd_off(D0, 3, 1)>(vb);
    asm volatile("s_waitcnt lgkmcnt(0)" ::: "memory"); SBAR();
#define PK(L, H) (bf16x8){L[0], L[1], L[2], L[3], H[0], H[1], H[2], H[3]}
    od = __builtin_amdgcn_mfma_f32_32x32x16_bf16(pa0, PK(l0, h0), od, 0, 0, 0);
    od = __builtin_amdgcn_mfma_f32_32x32x16_bf16(pa1, PK(l1, h1), od, 0, 0, 0);
    od = __builtin_amdgcn_mfma_f32_32x32x16_bf16(pa2, PK(l2, h2), od, 0, 0, 0);
    od = __builtin_amdgcn_mfma_f32_32x32x16_bf16(pa3, PK(l3, h3), od, 0, 0, 0);
#undef PK
}
__device__ __forceinline__ void pv_d0(f32x16* o, int vb, bf16x8 pa0, bf16x8 pa1, bf16x8 pa2, bf16x8 pa3) {
    pv_one<0>(o[0], vb, pa0, pa1, pa2, pa3); pv_one<1>(o[1], vb, pa0, pa1, pa2, pa3); pv_one<2>(o[2], vb, pa0, pa1, pa2, pa3); pv_one<3>(o[3], vb, pa0, pa1, pa2, pa3);
}

__device__ __forceinline__ void attn_unit(const bf16_t* __restrict__ P, bf16_t* __restrict__ Y, int qrow0, int krow0, int nkeys, int h, float lam, float osc, const float* __restrict__ subln_g, char* lds, unsigned long long* g_ts, int wv0) {
    const int tid = opaque_tid(wv0), wid = tid >> 6, lane = tid & 63, r32 = lane & 31, hi = lane >> 5, rg = wid & 3, comp = wid >> 2;
    char* V_lds = lds + OFF_V; char* K_lds = lds + OFF_K;
    float* ws = (float*)(lds + OFF_WS) + wid * 64; float* li_l = ws; float* al_l = ws + 32;
    float m_reg = -1e30f, l_reg = 0; f32x16 o[4] = {}; bf16x8 qr[4];
    const bf16_t* Qw = P + (size_t)(qrow0 + rg * 32 + r32) * N_IN + C_Q + h * 128 + comp * 64 + hi * 8;
#pragma unroll
    for (int d0 = 0; d0 < 4; ++d0) qr[d0] = *reinterpret_cast<const bf16x8*>(Qw + d0 * 16);
    const bf16_t* Kh = P + (size_t)krow0 * N_IN + C_K + h * 128; const bf16_t* Vh = P + (size_t)krow0 * N_IN + C_V + h * 128;
    const int sr = tid >> 4, sc = (tid & 15) * 8, vst0 = v_st(sr, sc), vst1 = v_st(32 + sr, sc);
    const int vb0 = (int)(uintptr_t)V_lds + v_rd_base(lane);
    const int cbase = comp * 128;
    struct { bf16x8 vs0, vs1, ks0, ks1; } sr_[2];
#define SLOAD(i, k0) do { sr_[i].vs0 = *reinterpret_cast<const bf16x8*>(&Vh[(size_t)((k0) + sr) * N_IN + sc]); sr_[i].vs1 = *reinterpret_cast<const bf16x8*>(&Vh[(size_t)((k0) + 32 + sr) * N_IN + sc]); \
    sr_[i].ks0 = *reinterpret_cast<const bf16x8*>(&Kh[(size_t)((k0) + sr) * N_IN + sc]); sr_[i].ks1 = *reinterpret_cast<const bf16x8*>(&Kh[(size_t)((k0) + 32 + sr) * N_IN + sc]); } while (0)
#define SWRITE(b, i) do { *(bf16x8*)(V_lds + (b) * SHM_V + vst0) = sr_[i].vs0; *(bf16x8*)(V_lds + (b) * SHM_V + vst1) = sr_[i].vs1; const int kc = sc * 2; \
    *(bf16x8*)(K_lds + (b) * SHM_K + KSWZ(sr, kc)) = sr_[i].ks0; *(bf16x8*)(K_lds + (b) * SHM_K + KSWZ(32 + sr, kc)) = sr_[i].ks1; } while (0)
#define SWAIT() asm volatile("s_waitcnt vmcnt(4)" ::: "memory")
#define RESC(a) do { if (__any((a) < 1.f)) { if (hi == 0) al_l[r32] = (a); asm volatile("s_waitcnt lgkmcnt(0)" ::: "memory"); \
    _Pragma("unroll") for (int d = 0; d < 4; ++d) _Pragma("unroll") for (int r = 0; r < 16; ++r) o[d][r] *= al_l[crow(r, hi)]; } } while (0)
    f32x16 pA0, pA1, pB0, pB1; float mnA, mnB, alA, alB; bf16x8 pa0, pa1, pa2, pa3; const int NT = nkeys / KVBLK;
    constexpr int SE = 0, SO = 1;
    SLOAD(SE, 0); asm volatile("s_waitcnt vmcnt(0)" ::: "memory"); SWRITE(0, SE); __syncthreads();
    qkt(pA0, pA1, K_lds, qr, r32, hi, cbase); partialSM(pA0, pA1, m_reg, mnA, alA);
    SLOAD(SO, KVBLK); if (2 < NT) SLOAD(SE, 2 * KVBLK);
    SWAIT(); SWRITE(1, SO); __syncthreads();
    for (int j = 1; j + 1 < NT; j += 2) {
        SBAR(); qkt(pB0, pB1, K_lds + SHM_K, qr, r32, hi, cbase);
        finishSM(pA0, pA1, alA, l_reg, pa0, pa1, pa2, pa3); SBAR();
        SLOAD(SO, (j + 2) * KVBLK); SBAR();
        pv_d0(o, vb0, pa0, pa1, pa2, pa3); partialSM(pB0, pB1, m_reg, mnB, alB);
        __syncthreads(); SWAIT(); SWRITE(0, SE);
        RESC(alB); __syncthreads();
        SBAR(); qkt(pA0, pA1, K_lds, qr, r32, hi, cbase);
        finishSM(pB0, pB1, alB, l_reg, pa0, pa1, pa2, pa3); SBAR();
        if (j + 3 < NT) SLOAD(SE, (j + 3) * KVBLK); SBAR();
        pv_d0(o, vb0 + SHM_V, pa0, pa1, pa2, pa3); partialSM(pA0, pA1, m_reg, mnA, alA);
        __syncthreads(); SWAIT(); SWRITE(1, SO);
        RESC(alA); __syncthreads();
    }
    SBAR(); qkt(pB0, pB1, K_lds + SHM_K, qr, r32, hi, cbase);
    finishSM(pA0, pA1, alA, l_reg, pa0, pa1, pa2, pa3); SBAR();
    pv_d0(o, vb0, pa0, pa1, pa2, pa3); partialSM(pB0, pB1, m_reg, mnB, alB);
    __syncthreads(); RESC(alB);
    finishSM(pB0, pB1, alB, l_reg, pa0, pa1, pa2, pa3); SBAR();
    pv_d0(o, vb0 + SHM_V, pa0, pa1, pa2, pa3);
    if (hi == 0) li_l[r32] = l_reg; asm volatile("s_waitcnt lgkmcnt(0)" ::: "memory");
#pragma unroll
    for (int r = 0; r < 16; ++r) { const float rl = __builtin_amdgcn_rcpf(li_l[crow(r, hi)]);
#pragma unroll
        for (int d0 = 0; d0 < 4; ++d0) o[d0][r] *= rl; }
    __syncthreads();
    float* X = (float*)lds + (size_t)rg * 64 * 64 + lane;
    if (comp == 1) {
#pragma unroll
        for (int d0 = 0; d0 < 4; ++d0)
#pragma unroll
            for (int r = 0; r < 16; ++r) X[(d0 * 16 + r) * 64] = o[d0][r];
    }
    __syncthreads();
    if (comp == 0) {
        float rs[16];
#pragma unroll
        for (int r = 0; r < 16; ++r) { float ss = 0.f;
#pragma unroll
            for (int d0 = 0; d0 < 4; ++d0) { o[d0][r] -= lam * X[(d0 * 16 + r) * 64]; ss += o[d0][r] * o[d0][r]; }
#pragma unroll
            for (int x = 1; x < 32; x <<= 1) ss += __shfl_xor(ss, x);
            rs[r] = rsqrtf(ss * (1.f / 128.f) + EPS) * osc; }
#pragma unroll
        for (int d0 = 0; d0 < 4; ++d0) { const int col = d0 * 32 + r32; const float sg = subln_g[col];
#pragma unroll
            for (int r = 0; r < 16; ++r) { const size_t row = (size_t)(qrow0 + rg * 32 + crow(r, hi));
                const float g = bf2f(P[row * N_IN + C_GA + h * 128 + col]);
                Y[row * DM + h * 128 + col] = (bf16_t)f2bf(o[d0][r] * rs[r] * sg * silu_f(g)); } }
    }
    __syncthreads();
#undef SLOAD
#undef SWRITE
#undef SWAIT
#undef RESC
}
#undef KSWZ
#undef SBAR
}

namespace mixu {
constexpr int TT = 32;
constexpr int OFF_A = 0;
constexpr int OFF_B = 65536;
constexpr int AB_STRIDE = 1040;
struct Args { const bf16_t* P; bf16_t* Y; const bf16_t* wpool_t; const float* pool_scale; const float* w_dw; const float* b_dw; const float* ln_g; const float* ln_b; const bf16_t* wpw2_t; };
__device__ __forceinline__ float bflo(unsigned w) { return __uint_as_float(w << 16); }
__device__ __forceinline__ float bfhi(unsigned w) { return __uint_as_float(w & 0xffff0000u); }
__device__ __forceinline__ float ldsbf(const LAS unsigned char* p) { return bf2f(*(const LAS bf16_t*)p); }

__device__ __forceinline__ void wave_sum4(float (&v)[4]) {
#pragma unroll
    for (int o = 1; o < 64; o <<= 1) {
#pragma unroll
        for (int q = 0; q < 4; ++q) v[q] += __shfl_xor(v[q], o); }
}
__device__ __forceinline__ void mix_unit(const Args& a, int row0, LAS unsigned char* lds, unsigned long long* g_ts, int wv0) {
    const int tid = opaque_tid(wv0), wid = __builtin_amdgcn_readfirstlane(tid >> 6), lane = tid & 63, fr = lane & 15, fq = lane >> 4;
    const int b = row0 / TPB, t0 = row0 % TPB; const bool isctx = t0 < CTX;
    const int seq0 = b * TPB + (isctx ? 0 : CTX), L = isctx ? CTX : SEQ, tl0 = isctx ? t0 : t0 - CTX;
    LAS unsigned char* rA = lds + OFF_A; LAS unsigned char* rB = lds + OFF_B; LAS float* ys = (LAS float*)rB;
    const bf16_t* P = a.P;
    const int g = wid >> 1, nh = wid & 1;
    STAMPI(59);
    bf16x8 bfr[4][4]; u32x2 gwp[4][2]; f32x4 ps[4]; float w[31];
    { const bf16_t* wt = a.wpool_t + (size_t)g * 128 * 128 + (size_t)(nh * 4) * 4 * 512 + lane * 8;
#pragma unroll
      for (int nb = 0; nb < 4; ++nb) {
#pragma unroll
          for (int ks = 0; ks < 4; ++ks) bfr[nb][ks] = *(const bf16x8*)(wt + (nb * 4 + ks) * 512); } }
#pragma unroll
    for (int j = 0; j < 31; ++j) w[j] = a.w_dw[j * 512 + tid];
    const float bias = a.b_dw[tid];
#pragma unroll 1
    for (int i = 0; i < 14; ++i) {
        const bool up = i < 6; const int p = (up ? i : i - 6) * 8 + wid, tl = tl0 - (up ? 8 : 15) + p;
        LAS unsigned char* dst = (up ? rB : rA) + p * 1024;
        if (up || p < TT + 30) {
            if (tl >= 0 && tl < L) __builtin_amdgcn_global_load_lds((const unsigned*)(P + (size_t)(seq0 + tl) * N_IN + (up ? C_UP : C_CA) + lane * 8), (LAS unsigned*)dst, 16, 0, 0);
            else { unsigned z = 0u; asm volatile("" : "+v"(z)); *(LAS u32x4*)(dst + lane * 16) = (u32x4){z, z, z, z}; }
        }
    }
    STAMPI(60);
    asm volatile("s_waitcnt vmcnt(0)" ::: "memory");
    __syncthreads();
    STAMPI(61);
#pragma unroll
    for (int nb = 0; nb < 4; ++nb) { const int n = g * 128 + nh * 64 + nb * 16 + fq * 4; ps[nb] = *(const f32x4*)(a.pool_scale + n);
#pragma unroll
        for (int m = 0; m < 2; ++m) gwp[nb][m] = *(const u32x2*)(P + ((size_t)row0 + m * 16 + fr) * N_IN + C_GP + n); }
    { const int HW = 1 << (wid >> 1); LAS unsigned char* col = rB + tid * 2; float s = 0.f;
      for (int p = 0; p < 2 * HW; ++p) s += ldsbf(col + (8 - HW + p) * 1024);
#pragma unroll 8
      for (int tk = 0; tk < TT; ++tk) { const int tl = tl0 + tk, lo = max(tl - HW, 0), hi = min(tl + HW, L);
          const float d = s * __builtin_amdgcn_rcpf((float)(hi - lo)) - ldsbf(col + (8 + tk) * 1024);
          s += ldsbf(col + (8 + HW + tk) * 1024) - ldsbf(col + (8 - HW + tk) * 1024);
          *(LAS bf16_t*)(col + tk * 1024) = (bf16_t)f2bf(d); } }
    __syncthreads();
    STAMPI(62);
    { bf16x8 af[2][4];
#pragma unroll
      for (int m = 0; m < 2; ++m)
#pragma unroll
          for (int ks = 0; ks < 4; ++ks) af[m][ks] = *(const LAS bf16x8*)(rB + (m * 16 + fr) * 1024 + (g * 128 + ks * 32 + fq * 8) * 2);
#pragma unroll
      for (int nb = 0; nb < 4; ++nb) { const int n = g * 128 + nh * 64 + nb * 16 + fq * 4;
#pragma unroll
          for (int m = 0; m < 2; ++m) { f32x4 acc = {0.f, 0.f, 0.f, 0.f};
#pragma unroll
              for (int ks = 0; ks < 4; ++ks) acc = __builtin_amdgcn_mfma_f32_16x16x32_bf16(bfr[nb][ks], af[m][ks], acc, 0, 0, 0);
              const f32x4 v = acc * ps[nb]; const u32x2 gw = gwp[nb][m];
              u32x2 o; o.x = pk2(v[0] * silu_f(bflo(gw.x)), v[1] * silu_f(bfhi(gw.x))); o.y = pk2(v[2] * silu_f(bflo(gw.y)), v[3] * silu_f(bfhi(gw.y)));
              *(u32x2*)(a.Y + ((size_t)row0 + m * 16 + fr) * DM + 1024 + n) = o; } } }
    const bf16_t* wt2 = a.wpw2_t + (size_t)(wid * 4) * 16 * 512 + lane * 8;
    bf16x8 bcur[16], bnxt[16]; u32x2 gcur[2];
#pragma unroll
    for (int ks = 0; ks < 16; ++ks) bcur[ks] = *(const bf16x8*)(wt2 + ks * 512);
    __syncthreads();
    STAMPI(63);
    { const LAS unsigned char* ucol = rA + tid * 2; float win[34];
#pragma unroll
      for (int i = 0; i < 30; ++i) win[i] = ldsbf(ucol + i * 1024);
#pragma unroll 1
      for (int it = 0; it < TT / 4; ++it) {
#pragma unroll
          for (int k = 0; k < 4; ++k) win[30 + k] = ldsbf(ucol + (30 + 4 * it + k) * 1024);
#pragma unroll
          for (int k = 0; k < 4; ++k) { float y = bias;
#pragma unroll
              for (int j = 0; j < 31; ++j) y += win[k + j] * w[j];
              ys[(4 * it + k) * 512 + tid] = y; }
#pragma unroll
          for (int i = 0; i < 30; ++i) win[i] = win[i + 4];
      } }
    __syncthreads();
    STAMPI(64);
    { float v[4][8], s[4], qq[4];
#pragma unroll
      for (int q = 0; q < 4; ++q) { s[q] = 0.f;
#pragma unroll
          for (int j = 0; j < 8; ++j) { v[q][j] = ys[(wid * 4 + q) * 512 + lane + 64 * j]; s[q] += v[q][j]; } }
      wave_sum4(s);
#pragma unroll
      for (int q = 0; q < 4; ++q) { const float mu = s[q] * (1.f / 512.f); qq[q] = 0.f;
#pragma unroll
          for (int j = 0; j < 8; ++j) { v[q][j] -= mu; qq[q] += v[q][j] * v[q][j]; } }
      wave_sum4(qq);
#pragma unroll
      for (int j = 0; j < 8; ++j) { const int c = lane + 64 * j; const float lg = a.ln_g[c], lb = a.ln_b[c];
#pragma unroll
          for (int q = 0; q < 4; ++q) { const float rs = rsqrtf(qq[q] * (1.f / 512.f) + EPS), z = v[q][j] * rs * lg + lb;
              *(LAS bf16_t*)(rA + (wid * 4 + q) * AB_STRIDE + c * 2) = (bf16_t)f2bf(silu_f(z)); } } }
    __syncthreads();
    STAMPI(65);
#pragma unroll 1
    for (int nb = 0; nb < 4; ++nb) {
        const int nn = min(nb + 1, 3);
#pragma unroll
        for (int ks = 0; ks < 16; ++ks) bnxt[ks] = *(const bf16x8*)(wt2 + (nn * 16 + ks) * 512);
        const int n = wid * 64 + nb * 16 + fq * 4;
#pragma unroll
        for (int m = 0; m < 2; ++m) gcur[m] = *(const u32x2*)(P + ((size_t)row0 + m * 16 + fr) * N_IN + C_GC + n);
        f32x4 acc[2] = {(f32x4){0.f, 0.f, 0.f, 0.f}, (f32x4){0.f, 0.f, 0.f, 0.f}};
#pragma unroll
        for (int ks = 0; ks < 16; ++ks)
#pragma unroll
            for (int m = 0; m < 2; ++m) { const bf16x8 af = *(const LAS bf16x8*)(rA + (m * 16 + fr) * AB_STRIDE + (ks * 32 + fq * 8) * 2);
                acc[m] = __builtin_amdgcn_mfma_f32_16x16x32_bf16(bcur[ks], af, acc[m], 0, 0, 0); }
#pragma unroll
        for (int m = 0; m < 2; ++m) { const f32x4 v = acc[m];
            u32x2 o; o.x = pk2(v[0] * silu_f(bflo(gcur[m].x)), v[1] * silu_f(bfhi(gcur[m].x))); o.y = pk2(v[2] * silu_f(bflo(gcur[m].y)), v[3] * silu_f(bfhi(gcur[m].y)));
            *(u32x2*)(a.Y + ((size_t)row0 + m * 16 + fr) * DM + 1536 + n) = o; }
#pragma unroll
        for (int ks = 0; ks < 16; ++ks) bcur[ks] = bnxt[ks];
    }
    __syncthreads();
    STAMPI(66);
}
}

#define XB_TMO      128
#define XB_XCNT(j)  (256  + 64 * (j))
#define XB_XSUB(j)  (1280 + 64 * (j))
#define XB_XGEN(j)  (2304 + 64 * (j))
#define XB_TOP      3328
#define XB_TOPGEN   3392
#define XCD_BAR_WORDS 3456
#define XB_SPIN_CAP (1u << 18)
__device__ __forceinline__ unsigned xb_ld(unsigned* p)              { return __hip_atomic_load(p, __ATOMIC_RELAXED, __HIP_MEMORY_SCOPE_AGENT); }
__device__ __forceinline__ unsigned xb_add(unsigned* p, unsigned v) { return __hip_atomic_fetch_add(p, v, __ATOMIC_RELAXED, __HIP_MEMORY_SCOPE_AGENT); }
__device__ __forceinline__ unsigned xb_xcc_id() { return (unsigned)__builtin_amdgcn_s_getreg((3 << 11) | 20) & 0xFu; }
#define XB_SPIN(cond, bar) do { unsigned _sp = 0; while (cond) { __builtin_amdgcn_s_sleep(1); \
    if ((++_sp & 255u) == 0u) { if (xb_ld(&(bar)[XB_TMO])) break; if (_sp > XB_SPIN_CAP) { atomicAdd(&(bar)[XB_TMO], 1u); break; } } } } while (0)
struct XcdBarrier { unsigned* bar; unsigned x; volatile LAS unsigned* st; };
__device__ __forceinline__ XcdBarrier xcd_barrier_post(unsigned* bar, volatile LAS unsigned* st) {
    XcdBarrier b; b.bar = bar; b.x = xb_xcc_id(); b.st = st;
    if (threadIdx.x == 0) (void)xb_add(&bar[XB_XCNT(b.x)], 1u);
    return b;
}
__device__ __forceinline__ void xcd_barrier_complete(unsigned* bar, unsigned x, unsigned& nloc, unsigned& nx) {
    const unsigned G = gridDim.x * gridDim.y * gridDim.z;
    unsigned sum, cnt, mine, sp = 0u;
    for (;;) {
        sum = 0u; cnt = 0u; mine = 0u;
#pragma unroll
        for (unsigned j = 0; j < 16; ++j) { const unsigned c = xb_ld(&bar[XB_XCNT(j)]); sum += c; cnt += (c > 0u) ? 1u : 0u; mine = (j == x) ? c : mine; }
        if (sum == G) break;
        __builtin_amdgcn_s_sleep(1);
        if ((++sp & 255u) == 0u) { if (xb_ld(&bar[XB_TMO])) break; if (sp > XB_SPIN_CAP) { atomicAdd(&bar[XB_TMO], 1u); break; } }
    }
    nloc = mine > 0u ? mine : 1u; nx = cnt > 0u ? cnt : 1u;
}
__device__ __forceinline__ void xcd_barrier(const XcdBarrier& b, int wv0) {
    asm volatile("s_waitcnt vmcnt(0)" ::: "memory");
    __syncthreads();
    if (wv0 == 0 && lane_id() == 0) {
        unsigned* bar = b.bar;
        __builtin_amdgcn_s_waitcnt(0);
        unsigned nloc = b.st[0], nx = b.st[1];
        if (nloc == 0u) { xcd_barrier_complete(bar, b.x, nloc, nx); b.st[0] = nloc; b.st[1] = nx; }
        const unsigned old = xb_add(&bar[XB_XSUB(b.x)], 1u);
        const unsigned gen = old / nloc;
        if (old + 1u == (gen + 1u) * nloc) {
            __builtin_amdgcn_fence(__ATOMIC_RELEASE, "agent");
            asm volatile("s_waitcnt vmcnt(0)" ::: "memory");
            const unsigned og = xb_add(&bar[XB_TOP], 1u);
            const unsigned tg = og / nx;
            if (og + 1u == (tg + 1u) * nx) xb_add(&bar[XB_TOPGEN], 1u);
            else XB_SPIN(xb_ld(&bar[XB_TOPGEN]) == tg, bar);
            __builtin_amdgcn_fence(__ATOMIC_ACQUIRE, "agent");
            xb_add(&bar[XB_XGEN(b.x)], 1u);
            asm volatile("s_waitcnt vmcnt(0)" ::: "memory");
        } else {
            XB_SPIN(xb_ld(&bar[XB_XGEN(b.x)]) == gen, bar);
            __builtin_amdgcn_fence(__ATOMIC_ACQUIRE, "agent");
            asm volatile("s_waitcnt vmcnt(0)" ::: "memory");
        }
    }
    __syncthreads();
}

__device__ __forceinline__ int win_dest_row(int n) { if (n < C_CA || n >= C_GC) return n; const int isb = n >= C_CB ? 1 : 0, c = n - (isb ? C_CB : C_CA); return C_CA + (c >> 4) * 32 + (isb << 4) + (c & 15); }
__device__ __forceinline__ size_t frag_off(int n, int k, int nks) { return ((size_t)(((n >> 6) * 4 + ((n >> 4) & 3)) * nks + (k >> 5)) * 64 + ((k >> 3) & 3) * 16 + (n & 15)) * 8; }
template <int MODE  , int K, int N> __device__ __forceinline__ void p0_transpose_item(const float* W, bf16_t* WT, LAS float* scr, int item, int lane) {
    const int nblk = N / 32, kb = item / nblk, nb = item % nblk, k0 = 64 * kb, n0 = 32 * nb;
    float tv[32];
    const float* Wp = W + (size_t)(k0 + (lane >> 5)) * N + n0 + (lane & 31);
#pragma unroll
    for (int i = 0; i < 32; ++i) tv[i] = Wp[(size_t)(2 * i) * N];
#pragma unroll
    for (int i = 0; i < 32; ++i) scr[(2 * i + (lane >> 5)) * 33 + (lane & 31)] = tv[i];
    asm volatile("s_waitcnt lgkmcnt(0)" ::: "memory");
    const int c = lane & 7;
#pragma unroll
    for (int j = 0; j < 4; ++j) { const int n = (lane >> 3) + 8 * j; const LAS float* s = scr + (8 * c) * 33 + n;
        u32x4 o; o.x = pk2(s[0 * 33], s[1 * 33]); o.y = pk2(s[2 * 33], s[3 * 33]); o.z = pk2(s[4 * 33], s[5 * 33]); o.w = pk2(s[6 * 33], s[7 * 33]);
        if (MODE == 2) *(u32x4*)(WT + frag_off(n0 + n, k0 + 8 * c, K / 32)) = o;
        else *(u32x4*)(WT + (size_t)(MODE == 1 ? win_dest_row(n0 + n) : n0 + n) * K + k0 + 8 * c) = o; }
    asm volatile("s_waitcnt lgkmcnt(0)" ::: "memory");
}

struct Args {
    const float* in[22]; float* out; unsigned char* ws; int ph_lo, ph_hi;
};

__device__ __forceinline__ void norm_row(const float* __restrict__ xsrc, const float* __restrict__ csrc, int cslices, const float* __restrict__ g, const float* __restrict__ MODl, bf16_t* __restrict__ H, int row, int lane) {
    const int b = row / TPB, t = row % TPB; const bool isctx = t < CTX;
    const float* src = isctx ? csrc + ((size_t)b * CTX + t) * DM : xsrc + ((size_t)b * SEQ + (t - CTX)) * DM;
    const float* mod = MODl + (size_t)(isctx ? 4 : b) * N_MOD;
    f32x4 v[8]; float ss = 0.f;
#pragma unroll
    for (int j = 0; j < 8; ++j) { v[j] = ((const f32x4*)src)[lane + 64 * j];
        if (isctx) for (int sl = 1; sl < cslices; ++sl) v[j] += ((const f32x4*)(src + (size_t)sl * (BATCH * CTX * DM)))[lane + 64 * j];
        ss += (v[j][0] * v[j][0] + v[j][1] * v[j][1]) + (v[j][2] * v[j][2] + v[j][3] * v[j][3]); }
    ss = wave_sum(ss);
    const float rstd = rsqrtf(ss * (1.f / DM) + EPS);
#pragma unroll
    for (int j = 0; j < 8; ++j) { const int col = (lane + 64 * j) * 4;
        const f32x4 gg = *(const f32x4*)(g + col), sh = *(const f32x4*)(mod + col), sc = *(const f32x4*)(mod + 2048 + col);
        const f32x4 o = v[j] * rstd * gg * (sc + 1.f) + sh;
        u32x2 w; w.x = pk2(o[0], o[1]); w.y = pk2(o[2], o[3]);
        *(u32x2*)(H + (size_t)row * DM + col) = w; }
}

__global__ void __launch_bounds__(NTHREADS, 2) mega_fwd(Args args) {
    extern __shared__ __attribute__((aligned(16))) unsigned char lds_raw[];
    LAS unsigned char* lds = (LAS unsigned char*)lds_raw;
    const int wv0 = __builtin_amdgcn_readfirstlane(threadIdx.x >> 6);
    const int G = gridDim.x, bx = blockIdx.x; const int vcu = (G % 8 == 0) ? (bx % 8) * (G / 8) + bx / 8 : bx;
    unsigned char* ws = args.ws;
    unsigned* ctl = (unsigned*)(ws + WS_CTL);
    unsigned long long* g_ts = (unsigned long long*)(ws + WS_CTL + 32768); (void)g_ts;
    STAMP(0);
    const float* x = args.in[0]; const float* c_in = args.in[1]; const float* ctx = args.in[2]; const float* c_ctx = args.in[3];
    const float* w_mod = args.in[4]; const float* b_mod = args.in[5]; const float* norm_g = args.in[6]; const float* w_in = args.in[7];
    const float* subln_g = args.in[12]; const float* w_pool = args.in[13]; const float* pool_scale = args.in[14]; const float* w_dw = args.in[15];
    const float* b_dw = args.in[16]; const float* ln_g = args.in[17]; const float* ln_b = args.in[18]; const float* w_pw2 = args.in[19];
    const float* w_out = args.in[20]; const float* final_g = args.in[21];
    float* out = args.out;
    float* ROPE = (float*)(ws + WS_ROPE); float* MOD = (float*)(ws + WS_MOD);
    bf16_t* WIN = (bf16_t*)(ws + WS_WIN); bf16_t* WOUT = (bf16_t*)(ws + WS_WOUT); bf16_t* WPW2 = (bf16_t*)(ws + WS_WPW2); bf16_t* WPOOL = (bf16_t*)(ws + WS_WPOOL);
    float* CTXS = (float*)(ws + WS_CTXS); bf16_t* H = (bf16_t*)(ws + WS_H); bf16_t* P = (bf16_t*)(ws + WS_P); bf16_t* Y = (bf16_t*)(ws + WS_YMIX);

#if MK_USE_CG
    cg::grid_group grid = cg::this_grid();
#define SEAM() do { __syncthreads(); grid.sync(); } while (0)
#else
#if MK_COOP
    if (args.ph_lo < 0) cg::this_grid().sync();
#endif
    for (int u = threadIdx.x; u < (LDS_BYTES - LDSCTL_OFF) / 4; u += NTHREADS) ((LAS unsigned*)(lds + LDSCTL_OFF))[u] = 0u;
    __syncthreads();
    XcdBarrier bar = xcd_barrier_post(ctl + CW_BAR, (volatile LAS unsigned*)(lds + MISC_OFF) + 8);
#define SEAM() xcd_barrier(bar, wv0)
#endif
    const int NGW = G * NWAVES;
#define PHASE_IDS() const int tid = opaque_tid(wv0), lane = tid & 63, wave = __builtin_amdgcn_readfirstlane(tid >> 6), gw = vcu * NWAVES + wave; (void)gw; (void)lane
    constexpr int NMODI = 2 * (DM / 256) * (N_MOD / 256);
    constexpr int I_WIN = (DM / 64) * (N_IN / 32), I_WOUT = (DM / 64) * (DM / 32), I_PW2 = (512 / 64) * (512 / 32), I_POOL = 4 * (128 / 64) * (128 / 32);
    constexpr int TR_A = I_WIN + I_PW2 + I_POOL, TR_B = TR_A + I_WOUT, TR_END = TR_B + I_WIN + I_WOUT + I_PW2 + I_POOL;
    static_assert(TR_A % 8 == 0 && TR_B % 8 == 0 && TR_END % 8 == 0, "transpose ranges are whole block-items");

#pragma unroll 1
    for (int ph = args.ph_lo; ph < args.ph_hi; ++ph) {
        const int l = ph == 0 ? 0 : (ph - 1) >> 2, kind = ph == 0 ? 0 : (ph == 9 ? 5 : 1 + ((ph - 1) & 3));
        const float* MODl = MOD + (size_t)l * 5 * N_MOD;
        const float* xsrc = l == 0 ? x : out; const float* csrc = l == 0 ? ctx : CTXS;
        const bool last = (l == DEPTH - 1);
        STAMP(2 * ph);
        if (kind == 1) {
            PHASE_IDS();
            for (int rep = 0; rep < REP_NORM; ++rep)
            for (int row = gw; row < M_TOT; row += NGW) norm_row(xsrc, csrc, l == 0 ? 1 : 4, norm_g + l * DM, MODl, H, row, lane);
        }
        if (kind == 2) {
            pg8::Gemm g{H, WIN + (size_t)l * DM * N_IN, M_TOT, N_IN, DM, DM};
            const int Gg = (!last && G == 256) ? 240 : G;
            pg8::TileSched S; if (!last) S.init(36, N_IN / 256, 0, 0, Gg, bx); else S.init(32, N_IN / 256, 32, 1, G, bx);
            pg8::EpiIn E{P, ROPE};
            if (bx < Gg)
            for (int rep = 0; rep < REP_INPROJ; ++rep)
            pg8::gemm_phase<pg8::EpiIn, pg8::TileSched, true, true>(lds, g, S, E, wv0);
        }
        if (kind == 3) {
            const float lam_init = l == 0 ? 0.2f : 0.35550906f;
            const float lam = __uint_as_float(__builtin_amdgcn_readfirstlane(__float_as_uint(MOD[2 * 5 * N_MOD + l]))), osc = 1.f - lam_init;
            { mixu::Args ma{P, Y, WPOOL + (size_t)l * 4 * 128 * 128, pool_scale + l * 512, w_dw + (size_t)l * 31 * 512, b_dw + l * 512, ln_g + l * 512, ln_b + l * 512, WPW2 + (size_t)l * 512 * 512};
              const int ntiles = last ? BATCH * SEQ / 32 : M_TOT / 32;
              for (int rep = 0; rep < REP_MIX; ++rep)
              for (int t = vcu; t < ntiles; t += G) { int row0;
                  if (last) row0 = (t / 64) * TPB + CTX + (t % 64) * 32; else row0 = t * 32;
                  mixu::mix_unit(ma, row0, lds, g_ts, wv0); } }
            STAMP(40 + l);
            { constexpr int NUL = BATCH * HEADS * (SEQ / 128), NUC = BATCH * HEADS * (CTX / 128); const int upc = (NUL + G - 1) / G, ncx = last ? 0 : (NUC + G - 1) / G;
              for (int rep = 0; rep < REP_ATT; ++rep)
              for (int i = 0; i < upc + ncx; ++i) {
                  int qrow0, krow0, nkeys, h;
                  if (i < upc) { const int id = vcu * upc + i; if (id >= NUL) continue;
                      const int bh = id / (SEQ / 128), qb = id % (SEQ / 128), b = bh / HEADS; h = bh % HEADS; qrow0 = b * TPB + CTX + qb * 128; krow0 = b * TPB; nkeys = TPB; }
                  else { const int id = vcu + (i - upc) * G; if (id >= NUC) continue;
                      const int bh = id / (CTX / 128), qb = id % (CTX / 128), b = bh / HEADS; h = bh % HEADS; qrow0 = b * TPB + qb * 128; krow0 = b * TPB; nkeys = CTX; }
                  att::attn_unit(P, Y, qrow0, krow0, nkeys, h, lam, osc, subln_g + l * 128, (char*)lds_raw, g_ts, wv0); } }
        }
        if (kind == 4) {
            pg8::Gemm g{Y, WOUT + (size_t)l * DM * DM, M_TOT, DM, DM, DM};
            pg8::TileSched S; S.init(32, DM / 256, 0, 1, G, bx);
            pg8::EpiOut E{xsrc, csrc, out, CTXS, MODl};
            for (int rep = 0; rep < (last ? 1 : REP_OUT); ++rep)
            pg8::gemm_phase<pg8::EpiOut, pg8::TileSched, true, true>(lds, g, S, E, wv0);
            if (!last) {
                pg8::Gemm gc{Y, WOUT + (size_t)l * DM * DM, M_TOT, DM, DM / 4, DM};
                pg8::TileSched Sc; Sc.init(0, DM / 256, 128, 0, G, bx, 1);
                pg8::gemm_phase<pg8::EpiOut, pg8::TileSched, true, true>(lds, gc, Sc, E, wv0);
            }
        }
        if (kind == 5) {
            PHASE_IDS();
            for (int row = gw; row < BATCH * SEQ; row += NGW) {
                f32x4* p = (f32x4*)(out + (size_t)row * DM); f32x4 v[8]; float ss = 0.f;
#pragma unroll
                for (int j = 0; j < 8; ++j) { v[j] = p[lane + 64 * j]; ss += (v[j][0] * v[j][0] + v[j][1] * v[j][1]) + (v[j][2] * v[j][2] + v[j][3] * v[j][3]); }
                const float rstd = rsqrtf(wave_sum(ss) * (1.f / DM) + EPS);
#pragma unroll
                for (int j = 0; j < 8; ++j) { const f32x4 gg = *(const f32x4*)(final_g + (lane + 64 * j) * 4); p[lane + 64 * j] = v[j] * rstd * gg; }
            }
        }
        { constexpr int N0 = NMODI / 2 + 1 + TR_A / 8;
          constexpr int ND1 = (TR_B - TR_A) / 8 + I_WIN / 8, ND2 = NMODI / 2 + (TR_END - TR_B - I_WIN) / 8;
          const int steal = (ph == 2) ? 1 : (ph == 4 ? 2 : 0);
          if (ph == 0 || steal) {
              PHASE_IDS();
              LAS int* jbox = (LAS int*)(lds + LDSCTL_OFF + 64);
              for (int rep = 0; rep < (ph == 0 ? REP_P0 : 1); ++rep)
              for (int j = bx; ; j += G) {
                  if (steal) { __syncthreads(); if (tid == 0) *jbox = (int)__hip_atomic_fetch_add(ctl + CW_STEAL + 64 * (steal - 1), 1u, __ATOMIC_RELAXED, __HIP_MEMORY_SCOPE_AGENT); __syncthreads(); j = *jbox; if (j >= (steal == 1 ? ND1 : ND2)) break; }
                  else if (j >= N0) break;
                  int it;
                  if (!steal) it = j < NMODI / 2 ? j : (j == NMODI / 2 ? NMODI : NMODI + 1 + (j - NMODI / 2 - 1));
                  else if (steal == 1) it = NMODI + 1 + TR_A / 8 + j;
                  else it = j < NMODI / 2 ? NMODI / 2 + j : NMODI + 1 + (TR_B + I_WIN) / 8 + (j - NMODI / 2);
                  for (int irep = 0; irep < (ph != 0 ? 1 : (it < NMODI ? REP_P0M : (it == NMODI ? 1 : REP_P0T))); ++irep)
                  if (it < NMODI) {
                      const int lm = it / (NMODI / 2), rem = it % (NMODI / 2), kg = rem / 24, cg = rem % 24, c4 = cg * 256 + lane * 4;
                      LAS float* sv = (LAS float*)lds; LAS f32x4* red = (LAS f32x4*)(lds + 8192);
                      __syncthreads();
                      for (int i = tid; i < 5 * 256; i += NTHREADS) { const int r = i >> 8, k = kg * 256 + (i & 255); const float v = r < 4 ? c_in[r * 2048 + k] : c_ctx[k]; sv[i] = v / (1.f + expf(-v)); }
                      __syncthreads();
                      f32x4 acc[5];
#pragma unroll
                      for (int r = 0; r < 5; ++r) acc[r] = (f32x4){0.f, 0.f, 0.f, 0.f};
                      const float* W = w_mod + (size_t)lm * DM * N_MOD + (size_t)(kg * 256 + wave * 32) * N_MOD + c4;
#pragma unroll 16
                      for (int k = 0; k < 32; ++k) { const f32x4 w = *(const f32x4*)(W + (size_t)k * N_MOD);
#pragma unroll
                          for (int r = 0; r < 5; ++r) acc[r] += w * sv[r * 256 + wave * 32 + k]; }
#pragma unroll
                      for (int r = 0; r < 5; ++r) red[(wave * 5 + r) * 64 + lane] = acc[r];
                      __syncthreads();
                      if (tid < 320 && irep == 0) { const int r = tid >> 6, ln = tid & 63; f32x4 v = red[r * 64 + ln];
#pragma unroll
                          for (int w8 = 1; w8 < 8; ++w8) v += red[(w8 * 5 + r) * 64 + ln];
                          if (kg == 0) v += *(const f32x4*)(b_mod + lm * N_MOD + cg * 256 + ln * 4);
                          float* dst = MOD + ((size_t)lm * 5 + r) * N_MOD + cg * 256 + ln * 4;
#pragma unroll
                          for (int e = 0; e < 4; ++e) __hip_atomic_fetch_add(dst + e, v[e], __ATOMIC_RELAXED, __HIP_MEMORY_SCOPE_AGENT); }
                      __syncthreads();
                  } else if (it == NMODI) {
                      for (int i = tid; i < 64 * 16; i += NTHREADS) { const int pos = i >> 4, fi = i & 15; const float inv = powf(10000.f, -(float)fi / 16.f), ang = (float)pos * inv;
                          ROPE[i * 2] = cosf(ang); ROPE[i * 2 + 1] = sinf(ang); }
                      if (tid < 2) { const int ll = tid; float a = 0.f, b = 0.f;
                          for (int i = 0; i < 64; ++i) { a += args.in[8][ll * 64 + i] * args.in[9][ll * 64 + i]; b += args.in[10][ll * 64 + i] * args.in[11][ll * 64 + i]; }
                          const float lam_init = 0.8f - 0.6f * expf(-0.3f * (float)ll);
                          MOD[2 * 5 * N_MOD + ll] = expf(a) - expf(b) + lam_init; }
                  } else {
                      LAS float* scr = (LAS float*)(lds + wave * 16384);
                      int r = (it - NMODI - 1) * 8 + wave;
                      int lw = 0; if (r >= TR_B) { lw = 1; r -= TR_B; } else if (r >= TR_A) { r = r - TR_A + I_WIN; } else if (r >= I_WIN) { r = r - I_WIN + I_WIN + I_WOUT; }
                      if (r < I_WIN) p0_transpose_item<1, DM, N_IN>(w_in + (size_t)lw * DM * N_IN, WIN + (size_t)lw * DM * N_IN, scr, r, lane);
                      else if ((r -= I_WIN) < I_WOUT) p0_transpose_item<0, DM, DM>(w_out + (size_t)lw * DM * DM, WOUT + (size_t)lw * DM * DM, scr, r, lane);
                      else if ((r -= I_WOUT) < I_PW2) p0_transpose_item<2, 512, 512>(w_pw2 + (size_t)lw * 512 * 512, WPW2 + (size_t)lw * 512 * 512, scr, r, lane);
                      else { r -= I_PW2; p0_transpose_item<2, 128, 128>(w_pool + (size_t)(lw * 4 + r / 8) * 128 * 128, WPOOL + (size_t)(lw * 4 + r / 8) * 128 * 128, scr, r % 8, lane); }
                  }
              }
          }
        }
        STAMP(2 * ph + 1);
        if (ph + 1 < args.ph_hi) SEAM();
    }
#if MK_PROBE
    STAMP(50);
    if (blockIdx.x == 0 && wv0 == 0 && lane_id() == 0) { const unsigned long long dt = (g_ts[PROBE_X1] - g_ts[PROBE_X0]) * PROBE_AMP, t0 = __builtin_amdgcn_s_memrealtime();
        while (__builtin_amdgcn_s_memrealtime() - t0 < dt) __builtin_amdgcn_s_sleep(8); }
#endif
#undef SEAM
}

extern "C" void kernel_launch(void* const* d_in, const int* in_sizes, int n_in, void* d_out, int out_size, void* d_ws, size_t ws_size, hipStream_t stream) {
    static int grid = 0;
    if (grid == 0) {
        if (n_in != 22 || ws_size < WS_END || out_size != BATCH * SEQ * DM) { fprintf(stderr, "kernel_launch: unexpected n_in %d / out %d / ws %zu\n", n_in, out_size, ws_size); grid = -1; return; }
        int dev = 0, cus = 0, per_cu = 0;
        if (hipGetDevice(&dev) != hipSuccess || hipDeviceGetAttribute(&cus, hipDeviceAttributeMultiprocessorCount, dev) != hipSuccess) { grid = -1; return; }
        if (hipFuncSetAttribute((const void*)mega_fwd, hipFuncAttributeMaxDynamicSharedMemorySize, LDS_BYTES) != hipSuccess) { fprintf(stderr, "kernel_launch: hipFuncSetAttribute failed\n"); grid = -1; return; }
        if (hipOccupancyMaxActiveBlocksPerMultiprocessor(&per_cu, (const void*)mega_fwd, NTHREADS, LDS_BYTES) != hipSuccess || per_cu < 1) { fprintf(stderr, "kernel_launch: occupancy query says %d blocks per CU\n", per_cu); grid = -1; return; }
        (void)hipGetLastError();
        grid = cus;
    }
    if (grid < 0) return;
    (void)hipMemsetAsync((char*)d_ws + WS_CTL, 0, CTL_ZERO_BYTES, stream);
    Args a{};
    for (int i = 0; i < 22; ++i) a.in[i] = (const float*)d_in[i];
    a.out = (float*)d_out; a.ws = (unsigned char*)d_ws;
#if MK_PER_PHASE
    for (int ph = 0; ph < 10; ++ph) { a.ph_lo = ph; a.ph_hi = ph + 1;
        void* kargs[] = {&a};
        hipError_t e = hipLaunchCooperativeKernel((void*)mega_fwd, dim3(grid), dim3(NTHREADS), kargs, LDS_BYTES, stream);
        if (e != hipSuccess) { fprintf(stderr, "kernel_launch: launch failed: %s\n", hipGetErrorString(e)); break; } }
#else
    a.ph_lo = 0; a.ph_hi = 10;
#if MK_COOP
    void* kargs[] = {&a};
    hipError_t e = hipLaunchCooperativeKernel((void*)mega_fwd, dim3(grid), dim3(NTHREADS), kargs, LDS_BYTES, stream);
#else
    hipLaunchKernelGGL(mega_fwd, dim3(grid), dim3(NTHREADS), LDS_BYTES, stream, a);
    hipError_t e = hipPeekAtLastError();
#endif
    if (e != hipSuccess) fprintf(stderr, "kernel_launch: launch failed: %s (grid %d)\n", hipGetErrorString(e), grid);
#endif
}
```

```cpp
#include <hip/hip_runtime.h>
#include <hip/hip_cooperative_groups.h>
#include <cstdint>
#include <cstdio>
#include <cmath>
namespace cg = cooperative_groups;

#ifndef MK_USE_CG
#define MK_USE_CG 0
#endif
#ifndef REP_P0
#define REP_P0 1
#endif
#ifndef DEFER_R1
#define DEFER_R1 1
#endif
#ifndef DEFER_R2
#define DEFER_R2 1
#endif
#ifndef REP_P0M
#define REP_P0M 1
#endif
#ifndef REP_P0T
#define REP_P0T 1
#endif
#ifndef REP_NORM
#define REP_NORM 1
#endif
#ifndef REP_INPROJ
#define REP_INPROJ 1
#endif
#ifndef REP_MIX
#define REP_MIX 1
#endif
#ifndef REP_ATT
#define REP_ATT 1
#endif
#ifndef REP_OUT
#define REP_OUT 1
#endif
#ifndef REP_MX_POOL
#define REP_MX_POOL 1
#endif
#ifndef REP_MX_GLU
#define REP_MX_GLU 1
#endif
#ifndef REP_MX_CONV
#define REP_MX_CONV 1
#endif
#ifndef REP_MX_LN
#define REP_MX_LN 1
#endif
#ifndef REP_MX_PW2
#define REP_MX_PW2 1
#endif
#ifndef MK_PROBE
#define MK_PROBE 0
#endif
#define PROBE_X0 14
#define PROBE_X1 15
#define PROBE_Y0 15
#define PROBE_Y1 16
#define PROBE_AMP 8
#if MK_PROBE
#define STAMP(k) do { if (blockIdx.x == 0 && wv0 == 0 && lane_id() == 0) { g_ts[(k)] = __builtin_amdgcn_s_memrealtime(); } } while (0)
#else
#define STAMP(k) do { } while (0)
#endif
#if MK_PROBE == 2
#define STAMPI(k) STAMP(k)
#else
#define STAMPI(k) do { } while (0)
#endif
#ifndef MK_COOP
#define MK_COOP 0
#endif
#ifndef MK_PER_PHASE
#define MK_PER_PHASE 0
#endif

constexpr int DM = 2048, BATCH = 4, SEQ = 2048, DEPTH = 2, CTX = 256;
constexpr int N_IN = 6656, N_MOD = 6144, HEADS = 8;
constexpr int TPB = CTX + SEQ;
constexpr int M_TOT = BATCH * TPB;
constexpr float EPS = 1e-6f;
constexpr int C_Q = 0, C_K = 1024, C_V = 2048, C_GA = 3072, C_UP = 4096, C_GP = 4608, C_CA = 5120, C_CB = 5632, C_GC = 6144;
constexpr int NWAVES = 8, NTHREADS = 512;

#define LAS __attribute__((address_space(3)))
#define GAS __attribute__((address_space(1)))
typedef unsigned short bf16_t;
typedef short bf16x8 __attribute__((ext_vector_type(8)));
typedef short s16x4 __attribute__((ext_vector_type(4)));
typedef float f32x4 __attribute__((ext_vector_type(4)));
typedef float f32x16 __attribute__((ext_vector_type(16)));
typedef unsigned u32x4 __attribute__((ext_vector_type(4)));
typedef unsigned u32x2 __attribute__((ext_vector_type(2)));

__device__ __forceinline__ float bf2f(bf16_t v) { return __uint_as_float(((unsigned)v) << 16); }
__device__ __forceinline__ unsigned f2bf(float f) { unsigned u = __float_as_uint(f); return (u + 0x7fffu + ((u >> 16) & 1u)) >> 16; }
__device__ __forceinline__ unsigned pk2(float lo, float hi) { return f2bf(lo) | (f2bf(hi) << 16); }
__device__ __forceinline__ unsigned cvt_pk_bf16(float lo, float hi) { unsigned r; asm volatile("v_cvt_pk_bf16_f32 %0, %1, %2" : "=v"(r) : "v"(lo), "v"(hi)); return r; }
__device__ __forceinline__ float silu_f(float v) { return v * __builtin_amdgcn_rcpf(1.f + __expf(-v)); }
__device__ __forceinline__ float sigm_f(float v) { return __builtin_amdgcn_rcpf(1.f + __expf(-v)); }
__device__ __forceinline__ float wave_sum(float v) {
#pragma unroll
    for (int o = 1; o < 64; o <<= 1) v += __shfl_xor(v, o);
    return v;
}

__device__ __forceinline__ int lane_id() { int t; asm volatile("v_mbcnt_lo_u32_b32 %0, -1, 0\n\tv_mbcnt_hi_u32_b32 %0, -1, %0" : "=v"(t)); return t; }
__device__ __forceinline__ int opaque_tid(int wv0) { return wv0 * 64 + lane_id(); }

constexpr size_t MiB = 1u << 20;
constexpr size_t WS_CTL = 0, CTL_ZERO_BYTES = 64 * 1024 + 2 * 5 * 6144 * 4;
constexpr size_t WS_ROPE = 512 * 1024;
constexpr size_t WS_MOD = 64 * 1024;
constexpr size_t WS_WIN = 2 * MiB;
constexpr size_t WS_WOUT = 54 * MiB;
constexpr size_t WS_WPW2 = 70 * MiB;
constexpr size_t WS_WPOOL = 71 * MiB;
constexpr size_t WS_CTXRES = 72 * MiB;
constexpr size_t WS_H = 80 * MiB;
constexpr size_t WS_P = 116 * MiB;
constexpr size_t WS_YMIX = 234 * MiB;
constexpr size_t WS_CTXS = 270 * MiB;
constexpr size_t WS_END = 302 * MiB;
constexpr int CW_BAR = 1024;
constexpr int CW_STEAL = 512;

constexpr int RING_BYTES = 131072;
constexpr int LDSCTL_OFF = RING_BYTES, MISC_OFF = LDSCTL_OFF + 320;
constexpr int LDS_BYTES = 147456;

namespace pg8 {
constexpr int BM = 256, BK = 64, HALF = 128, HTB = HALF * BK * 2, STAGE_BYTES = 8 * HTB, NXCD = 8, WGM = 8;
__host__ __device__ __forceinline__ int lds_byte(int r, int c) { const int st = (r >> 4) * 2 + (c >> 5), rr = r & 15, cc = c & 31, ob = rr * 64 + cc * 2; return st * 1024 + (ob ^ (((ob >> 9) & 1) << 5)); }
__host__ __device__ __forceinline__ void stage_rc(int b, int& R, int& C) { const int st = b / 1024, sb = b % 1024, swz = sb ^ (((sb >> 9) & 1) << 5); R = (st >> 1) * 16 + swz / 64; C = (st & 1) * 32 + (swz % 64) / 2; }
__host__ __device__ __forceinline__ int perm32(int rho) { const int n = rho >> 4, i = rho & 15; return 8 * (i >> 2) + 4 * n + (i & 3); }

struct Unit { int pm, pn, ks; };
struct Gemm { const bf16_t* A; const bf16_t* Bt; int M, N, K, ld; };

struct TileSched {
    int nM, nN, nreg, nwg, G, c, lat_only, slices;
    __device__ void init(int nM_, int nN_, int nextra, int lat_only_, int G_, int c_, int slices_ = 0) { nM = nM_; nN = nN_; nreg = nM_ * nN_; nwg = nreg + nextra; lat_only = lat_only_; G = G_; c = c_; slices = slices_; }
    __device__ bool next(int i, Unit& u) const {
        const long L = (long)i * G + c; if (L >= nwg) return false;
        int wgid = (int)L; { const int q = nwg / NXCD, r = nwg % NXCD, xcd = wgid % NXCD, off = wgid / NXCD; wgid = (xcd < r ? xcd * (q + 1) : r * (q + 1) + (xcd - r) * q) + off; }
        if (wgid < nreg) {
            const int nig = WGM * nN, gid = wgid / nig, fm = gid * WGM, gsz = (nM - fm) < WGM ? (nM - fm) : WGM;
            const int j = fm + ((wgid % nig) % gsz); u.pn = (wgid % nig) / gsz;
            u.pm = lat_only ? (j >> 3) * 9 + 1 + (j & 7) : j;
            u.ks = 0;
        } else if (slices) { const int e = wgid - nreg; u.pm = (e >> 5) * 9; u.pn = (e >> 2) & 7; u.ks = e & 3; }
        else { const int e = wgid - nreg; u.pm = (e >> 3) * 9; u.pn = 4 + (e & 7); u.ks = 0; }
        return true;
    }
    __device__ __forceinline__ void a_ready(const Unit&) const {}
    __device__ __forceinline__ void done(const Unit&) const {}
};

struct EpiIn {
    static constexpr bool PERM = false, AFTER_DRAIN = false;
    bf16_t* P; const float* rope;
    __device__ __forceinline__ void operator()(const f32x4 (&acc)[2][2][4][2], const Unit& u, int wr, int wc, int fr, int fq) const {
        const int bt = u.pm % 9; const bool do_rope = (u.pn < 8) && (bt != 0), glu = (u.pn >= 20) && (u.pn < 24);
        const int col0 = u.pn * BM + wc * 32 + 4 * fq;
#pragma unroll
        for (int ai = 0; ai < 2; ++ai)
#pragma unroll
            for (int m = 0; m < 4; ++m) {
                const int rl = ai * HALF + wr * 64 + m * 16 + fr; const size_t row = (size_t)u.pm * BM + rl;
                f32x4 cs = {1.f, 1.f, 1.f, 1.f}, sn = {0.f, 0.f, 0.f, 0.f};
                if (do_rope) { const int tl = (bt - 1) * 256 + rl, pos = (wc & 1) ? (tl & 63) : (tl >> 6);
                    const f32x4 a = *(const f32x4*)(rope + (pos * 16 + 4 * fq) * 2), b = *(const f32x4*)(rope + (pos * 16 + 4 * fq) * 2 + 4);
                    cs = (f32x4){a[0], a[2], b[0], b[2]}; sn = (f32x4){a[1], a[3], b[1], b[3]}; }
                bf16_t* rowp = P + row * N_IN + col0;
                if (glu) {
#pragma unroll
                    for (int bj = 0; bj < 2; ++bj) { const f32x4 v0 = acc[ai][bj][m][0], v1 = acc[ai][bj][m][1]; const int g32 = (u.pn - 20) * 8 + bj * 4 + wc;
                        u32x2 w0; w0.x = cvt_pk_bf16(v0[0] * sigm_f(v1[0]), v0[1] * sigm_f(v1[1])); w0.y = cvt_pk_bf16(v0[2] * sigm_f(v1[2]), v0[3] * sigm_f(v1[3]));
                        *(u32x2*)(P + row * N_IN + C_CA + g32 * 16 + 4 * fq) = w0; }
                } else {
#pragma unroll
                for (int bj = 0; bj < 2; ++bj) { const f32x4 v0 = acc[ai][bj][m][0], v1 = acc[ai][bj][m][1];
                    const f32x4 o0 = v0 * cs - v1 * sn, o1 = v1 * cs + v0 * sn;
                    u32x2 w0, w1; w0.x = cvt_pk_bf16(o0[0], o0[1]); w0.y = cvt_pk_bf16(o0[2], o0[3]); w1.x = cvt_pk_bf16(o1[0], o1[1]); w1.y = cvt_pk_bf16(o1[2], o1[3]);
                    *(u32x2*)(rowp + bj * HALF) = w0; *(u32x2*)(rowp + bj * HALF + 16) = w1; }
                }
            }
    }
};
struct EpiOut {
    static constexpr bool PERM = false, AFTER_DRAIN = false;
    const float* xin; const float* cin; float* xout; float* cout; const float* MODl;
    __device__ __forceinline__ void operator()(const f32x4 (&acc)[2][2][4][2], const Unit& u, int wr, int wc, int fr, int fq) const {
        const int bt = u.pm % 9, b = u.pm / 9; const bool lat = bt != 0;
        const int col0 = u.pn * BM + wc * 32 + 4 * fq;
        const float* gp = MODl + (size_t)(lat ? b : 4) * N_MOD + 4096 + col0;
        f32x4 gv[2][2];
#pragma unroll
        for (int bj = 0; bj < 2; ++bj)
#pragma unroll
            for (int n = 0; n < 2; ++n) gv[bj][n] = *(const f32x4*)(gp + bj * HALF + n * 16);
        const float* src = lat ? xin : cin; float* dst = lat ? xout : cout + (size_t)u.ks * (BATCH * CTX * DM); const bool addres = lat || u.ks == 0;
#pragma unroll
        for (int ai = 0; ai < 2; ++ai)
#pragma unroll
            for (int m = 0; m < 4; ++m) {
                const int rl = ai * HALF + wr * 64 + m * 16 + fr;
                const size_t off = (lat ? ((size_t)b * SEQ + (bt - 1) * 256 + rl) : ((size_t)b * CTX + rl)) * DM + col0;
#pragma unroll
                for (int bj = 0; bj < 2; ++bj)
#pragma unroll
                    for (int n = 0; n < 2; ++n) { f32x4 o = gv[bj][n] * acc[ai][bj][m][n]; if (addres) o += *(const f32x4*)(src + off + bj * HALF + n * 16); *(f32x4*)(dst + off + bj * HALF + n * 16) = o; }
            }
    }
};

template <class Epi, class Sched, bool ALIGN_EPI = false, bool SP2 = false>
__device__ __forceinline__ void gemm_phase(LAS unsigned char* lds, const Gemm g, const Sched& S, const Epi& E, int wv0) {
    const int tid = opaque_tid(wv0), wid = __builtin_amdgcn_readfirstlane(tid >> 6), lane = tid & 63, wr = wid >> 2, wc = wid & 3, fr = lane & 15, fq = lane >> 4;
    const int K = g.ld, nt = g.K / BK;
    unsigned voffA[2], voffB[2];
#pragma unroll
    for (int i = 0; i < 2; ++i) { int R, C; stage_rc(tid * 16 + i * 8192, R, C); const int Rb = Epi::PERM ? ((R & ~31) + perm32(R & 31)) : R;
        voffA[i] = (unsigned)(R * K + C) * 2u; voffB[i] = (unsigned)(Rb * K + C) * 2u; }
    const size_t kstep = (size_t)(BK * 2);
    const size_t hstep = (size_t)HALF * K * 2;
    const size_t tstep = 2 * hstep;
    const unsigned ldsw = (unsigned)wid * 1024u;
    const int aoff = lds_byte(wr * 64 + fr, fq * 8), boff = lds_byte(wc * 32 + fr, fq * 8);
#define PG8_SA(b, h) (((b) * 2 + (h)) * HTB)
#define PG8_SB(b, h) ((4 + (b) * 2 + (h)) * HTB)
#define PG8_STAGE(bufoff, gbase, voff) do { _Pragma("unroll") for (int _i = 0; _i < 2; ++_i) \
        __builtin_amdgcn_global_load_lds((const unsigned*)((const char*)(gbase) + (voff)[_i]), (LAS unsigned*)(lds + (bufoff) + ldsw + _i * 8192), 16, 0, 0); } while (0)
#define PG8_LDA(dst, b, h) do { _Pragma("unroll") for (int m = 0; m < 4; ++m) _Pragma("unroll") for (int k = 0; k < 2; ++k) dst[m][k] = *(const LAS bf16x8*)(lds + PG8_SA(b, h) + aoff + m * 2048 + k * 1024); } while (0)
#define PG8_LDB(dst, b, h) do { _Pragma("unroll") for (int n = 0; n < 2; ++n) _Pragma("unroll") for (int k = 0; k < 2; ++k) dst[n][k] = *(const LAS bf16x8*)(lds + PG8_SB(b, h) + boff + n * 2048 + k * 1024); } while (0)
#define PG8_MMA(ai, bj, At, Bt) do { __builtin_amdgcn_s_setprio(1); _Pragma("unroll") for (int m = 0; m < 4; ++m) _Pragma("unroll") for (int n = 0; n < 2; ++n) _Pragma("unroll") for (int k = 0; k < 2; ++k) \
        acc[ai][bj][m][n] = __builtin_amdgcn_mfma_f32_16x16x32_bf16(Bt[n][k], At[m][k], acc[ai][bj][m][n], 0, 0, 0); __builtin_amdgcn_s_setprio(0); } while (0)
#define PG8_WAIT_V(n) asm volatile("s_waitcnt vmcnt(" #n ")" ::: "memory")
#define PG8_WAIT_L(n) asm volatile("s_waitcnt lgkmcnt(" #n ")" ::: "memory")
#define PG8_BAR __builtin_amdgcn_s_barrier()
#define PG8_SCHED __builtin_amdgcn_sched_barrier(0)
    Unit cur, nxt; int ui = 0;
    if (!S.next(0, cur)) return;
    f32x4 acc[2][2][4][2];
#pragma unroll
    for (int a = 0; a < 2; ++a)
#pragma unroll
        for (int b = 0; b < 2; ++b)
#pragma unroll
            for (int m = 0; m < 4; ++m)
#pragma unroll
                for (int n = 0; n < 2; ++n) acc[a][b][m][n] = (f32x4){0.f, 0.f, 0.f, 0.f};
    bf16x8 At[4][2], B0[2][2], B1[2][2];
    const size_t sstep = (size_t)g.K * 2;
    const char* cA = (const char*)g.A + (size_t)cur.pm * tstep + cur.ks * sstep; const char* cB = (const char*)g.Bt + (size_t)cur.pn * tstep + cur.ks * sstep;
    S.a_ready(cur);
    if constexpr (SP2) {
        PG8_STAGE(PG8_SB(0, 0), cB, voffB); PG8_STAGE(PG8_SB(0, 1), cB + hstep, voffB); PG8_STAGE(PG8_SA(0, 0), cA, voffA); PG8_STAGE(PG8_SA(0, 1), cA + hstep, voffA);
        if (wr == 1) PG8_BAR;
        PG8_WAIT_V(2); PG8_BAR;
        PG8_STAGE(PG8_SB(1, 0), cB + kstep, voffB); PG8_STAGE(PG8_SA(1, 0), cA + kstep, voffA); PG8_STAGE(PG8_SB(1, 1), cB + hstep + kstep, voffB);
        PG8_WAIT_V(6); PG8_BAR;
    } else {
        PG8_STAGE(PG8_SB(0, 0), cB, voffB); PG8_STAGE(PG8_SA(0, 0), cA, voffA); PG8_STAGE(PG8_SB(0, 1), cB + hstep, voffB); PG8_STAGE(PG8_SA(0, 1), cA + hstep, voffA);
        if (wr == 1) PG8_BAR;
        PG8_WAIT_V(4); PG8_BAR;
        PG8_STAGE(PG8_SB(1, 0), cB + kstep, voffB); PG8_STAGE(PG8_SA(1, 0), cA + kstep, voffA); PG8_STAGE(PG8_SB(1, 1), cB + hstep + kstep, voffB);
        PG8_WAIT_V(6); PG8_BAR;
    }
    for (;;) {
        const bool has_next = S.next(ui + 1, nxt);
        const char* nA = has_next ? (const char*)g.A + (size_t)nxt.pm * tstep + nxt.ks * sstep : cA; const char* nB = has_next ? (const char*)g.Bt + (size_t)nxt.pn * tstep + nxt.ks * sstep : cB;
        for (int t = 0; t < nt; t += 2) {
            const bool last = (t == nt - 2);
            const char* a1 = cA + (size_t)(t + 1) * kstep;
            const char* a2 = last ? nA : cA + (size_t)(t + 2) * kstep; const char* b2 = last ? nB : cB + (size_t)(t + 2) * kstep;
            const char* a3 = a2 + kstep; const char* b3 = b2 + kstep;
            if (last && has_next) S.a_ready(nxt);
            if constexpr (SP2) {
            PG8_LDB(B0, 0, 0); PG8_LDB(B1, 0, 1); PG8_SCHED; PG8_LDA(At, 0, 0); PG8_STAGE(PG8_SA(1, 1), a1 + hstep, voffA);
            PG8_WAIT_V(8); PG8_WAIT_L(0); PG8_BAR; PG8_MMA(0, 0, At, B0); PG8_MMA(0, 1, At, B1); PG8_BAR; PG8_SCHED;
            PG8_LDA(At, 0, 1); PG8_STAGE(PG8_SB(0, 0), b2, voffB); PG8_STAGE(PG8_SB(0, 1), b2 + hstep, voffB); PG8_STAGE(PG8_SA(0, 0), a2, voffA);
            PG8_WAIT_V(8); PG8_WAIT_L(0); PG8_BAR; PG8_MMA(1, 0, At, B0); PG8_MMA(1, 1, At, B1); PG8_BAR; PG8_SCHED;
            PG8_LDB(B0, 1, 0); PG8_LDB(B1, 1, 1); PG8_SCHED; PG8_LDA(At, 1, 0); PG8_STAGE(PG8_SA(0, 1), a2 + hstep, voffA);
            PG8_WAIT_V(8); PG8_WAIT_L(0); PG8_BAR; PG8_MMA(0, 0, At, B0); PG8_MMA(0, 1, At, B1); PG8_BAR; PG8_SCHED;
            PG8_LDA(At, 1, 1); PG8_STAGE(PG8_SB(1, 0), b3, voffB); PG8_STAGE(PG8_SB(1, 1), b3 + hstep, voffB); PG8_STAGE(PG8_SA(1, 0), a3, voffA);
            PG8_WAIT_V(8); PG8_WAIT_L(0); PG8_BAR; PG8_MMA(1, 0, At, B0); PG8_MMA(1, 1, At, B1); PG8_BAR; PG8_SCHED;
            } else {
            PG8_LDB(B0, 0, 0); PG8_SCHED; PG8_LDA(At, 0, 0); PG8_STAGE(PG8_SA(1, 1), a1 + hstep, voffA);
            PG8_WAIT_L(8); PG8_BAR; PG8_WAIT_L(0); PG8_MMA(0, 0, At, B0); PG8_BAR; PG8_SCHED;
            PG8_LDB(B1, 0, 1); PG8_STAGE(PG8_SB(0, 0), b2, voffB);
            PG8_BAR; PG8_WAIT_L(0); PG8_MMA(0, 1, At, B1); PG8_BAR;
            PG8_LDA(At, 0, 1); PG8_STAGE(PG8_SA(0, 0), a2, voffA);
            PG8_BAR; PG8_WAIT_L(0); PG8_MMA(1, 0, At, B0); PG8_BAR; PG8_SCHED;
            PG8_STAGE(PG8_SB(0, 1), b2 + hstep, voffB);
            PG8_WAIT_V(6); PG8_BAR; PG8_MMA(1, 1, At, B1); PG8_BAR;
            PG8_LDB(B0, 1, 0); PG8_SCHED; PG8_LDA(At, 1, 0); PG8_STAGE(PG8_SA(0, 1), a2 + hstep, voffA);
            PG8_WAIT_L(8); PG8_BAR; PG8_WAIT_L(0); PG8_MMA(0, 0, At, B0); PG8_BAR; PG8_SCHED;
            PG8_LDB(B1, 1, 1); PG8_STAGE(PG8_SB(1, 0), b3, voffB);
            PG8_BAR; PG8_WAIT_L(0); PG8_MMA(0, 1, At, B1); PG8_BAR;
            PG8_LDA(At, 1, 1); PG8_STAGE(PG8_SA(1, 0), a3, voffA);
            PG8_BAR; PG8_WAIT_L(0); PG8_MMA(1, 0, At, B0); PG8_BAR; PG8_SCHED;
            PG8_STAGE(PG8_SB(1, 1), b3 + hstep, voffB);
            PG8_WAIT_V(6); PG8_BAR; PG8_MMA(1, 1, At, B1); PG8_BAR;
            }
        }
        if constexpr (ALIGN_EPI) { if (wr == 0) PG8_BAR; }
        if constexpr (!Epi::AFTER_DRAIN) { E(acc, cur, wr, wc, fr, fq); S.done(cur); }
        if (!has_next) break;
#pragma unroll
        for (int a = 0; a < 2; ++a)
#pragma unroll
            for (int b = 0; b < 2; ++b)
#pragma unroll
                for (int m = 0; m < 4; ++m)
#pragma unroll
                    for (int n = 0; n < 2; ++n) acc[a][b][m][n] = (f32x4){0.f, 0.f, 0.f, 0.f};
        cur = nxt; cA = nA; cB = nB; ++ui;
        if constexpr (ALIGN_EPI) { if (wr == 1) PG8_BAR; }
    }
    PG8_WAIT_V(0);
    if constexpr (!ALIGN_EPI) { if (wr == 0) PG8_BAR; }
    PG8_BAR;
#undef PG8_SA
#undef PG8_SB
#undef PG8_STAGE
#undef PG8_LDA
#undef PG8_LDB
#undef PG8_MMA
#undef PG8_WAIT_V
#undef PG8_WAIT_L
#undef PG8_BAR
#undef PG8_SCHED
}
}

namespace att {
constexpr int KVBLK = 64;
constexpr int SHM_V = KVBLK * 128 * 2, SHM_K = KVBLK * 128 * 2;
constexpr int OFF_V = 0, OFF_K = 2 * SHM_V, OFF_WS = 2 * SHM_V + 2 * SHM_K, ATT_LDS = OFF_WS + NWAVES * 64 * 4;
constexpr float SCALE = 0.125f, THR = 8.f;
#define KSWZ(row, colB) ((row) * 256 + ((colB) ^ (((row) & 7) << 4)))
#define SBAR() __builtin_amdgcn_sched_barrier(0)
__device__ __forceinline__ int crow(int r, int hi) { return (r & 3) + 8 * (r >> 2) + 4 * hi; }
__device__ __forceinline__ void partialSM(f32x16& p0, f32x16& p1, float& m_reg, float& mn, float& alpha) {
    constexpr float C = SCALE * 1.4426950408889634f;
    float pmax = p0[0];
#pragma unroll
    for (int r = 1; r < 16; ++r) pmax = fmaxf(pmax, p0[r]);
#pragma unroll
    for (int r = 0; r < 16; ++r) pmax = fmaxf(pmax, p1[r]);
    { auto rr = __builtin_amdgcn_permlane32_swap(__float_as_uint(pmax), __float_as_uint(pmax), false, false);
      pmax = fmaxf(__uint_as_float(rr[0]), __uint_as_float(rr[1])); }
    if (__builtin_expect(__all(pmax - m_reg <= THR / SCALE), 1)) { mn = m_reg; alpha = 1.f; }
    else { mn = fmaxf(m_reg, pmax); alpha = __builtin_amdgcn_exp2f((m_reg - mn) * C); m_reg = mn; }
    const float mnC = -mn * C;
#pragma unroll
    for (int r = 0; r < 16; ++r) p0[r] = fmaf(p0[r], C, mnC);
#pragma unroll
    for (int r = 0; r < 16; ++r) p1[r] = fmaf(p1[r], C, mnC);
#pragma unroll
    for (int r = 0; r < 16; ++r) p0[r] = __builtin_amdgcn_exp2f(p0[r]);
}
__device__ __forceinline__ void finishSM(f32x16& p0, f32x16& p1, float alpha, float& l_reg, bf16x8& pa0, bf16x8& pa1, bf16x8& pa2, bf16x8& pa3) {
#pragma unroll
    for (int r = 0; r < 16; ++r) p1[r] = __builtin_amdgcn_exp2f(p1[r]);
    float ps = 0;
#pragma unroll
    for (int r = 0; r < 16; ++r) ps += p0[r];
#pragma unroll
    for (int r = 0; r < 16; ++r) ps += p1[r];
    { auto rr = __builtin_amdgcn_permlane32_swap(__float_as_uint(ps), __float_as_uint(ps), false, false);
      ps = __uint_as_float(rr[0]) + __uint_as_float(rr[1]); }
    l_reg = l_reg * alpha + ps;
#define PK4(P, BASE, OUT) do { unsigned a0 = cvt_pk_bf16(P[BASE + 0], P[BASE + 1]), a1 = cvt_pk_bf16(P[BASE + 2], P[BASE + 3]);   \
    unsigned b0 = cvt_pk_bf16(P[BASE + 4], P[BASE + 5]), b1 = cvt_pk_bf16(P[BASE + 6], P[BASE + 7]);                              \
    auto r0 = __builtin_amdgcn_permlane32_swap(a0, b0, false, false); auto r1 = __builtin_amdgcn_permlane32_swap(a1, b1, false, false); \
    u32x4 w = {r0[0], r1[0], r0[1], r1[1]}; OUT = *reinterpret_cast<bf16x8*>(&w); } while (0)
    PK4(p0, 0, pa0); PK4(p0, 8, pa1); PK4(p1, 0, pa2); PK4(p1, 8, pa3);
#undef PK4
}
__device__ __forceinline__ void qkt(f32x16& p0, f32x16& p1, const char* Ks, const bf16x8* qr, int r32, int hi, int cbase) {
    p0 = f32x16{}; p1 = f32x16{};
#pragma unroll
    for (int d0 = 0; d0 < 4; ++d0) { const int cb = cbase + (d0 * 16 + hi * 8) * 2;
        const bf16x8 b0 = *reinterpret_cast<const bf16x8*>(Ks + KSWZ(r32, cb));
        const bf16x8 b1 = *reinterpret_cast<const bf16x8*>(Ks + KSWZ(32 + r32, cb));
        p0 = __builtin_amdgcn_mfma_f32_32x32x16_bf16(b0, qr[d0], p0, 0, 0, 0);
        p1 = __builtin_amdgcn_mfma_f32_32x32x16_bf16(b1, qr[d0], p1, 0, 0, 0); }
}
__device__ __forceinline__ int v_st(int k, int c) { const int kk = (k & ~0xC) | ((k & 4) << 1) | ((k & 8) >> 1); return ((kk >> 3) * 4 + (c >> 5)) * 512 + ((kk & 7) * 32 + (c & 31)) * 2; }
__device__ __forceinline__ int v_rd_base(int lane) { return ((lane & 3) << 3) | (((lane >> 2) & 3) << 6) | (((lane >> 4) & 1) << 5) | (((lane >> 5) & 1) << 8); }
constexpr int v_rd_off(int d0, int ks, int half) { return d0 * 512 + ks * 4096 + half * 2048; }
template <int OFF> __device__ __forceinline__ s16x4 tr_read(int vb) {
    s16x4 r; asm volatile("ds_read_b64_tr_b16 %0, %1 offset:%2" : "=&v"(r) : "v"(vb), "i"(OFF) : "memory"); return r;
}
template <int D0> __device__ __forceinline__ void pv_one(f32x16& od, int vb, bf16x8 pa0, bf16x8 pa1, bf16x8 pa2, bf16x8 pa3) {
    const s16x4 l0 = tr_read<v_rd_off(D0, 0, 0)>(vb), h0 = tr_read<v_rd_off(D0, 0, 1)>(vb), l1 = tr_read<v_rd_off(D0, 1, 0)>(vb), h1 = tr_read<v_rd_off(D0, 1, 1)>(vb);
    const s16x4 l2 = tr_read<v_rd_off(D0, 2, 0)>(vb), h2 = tr_read<v_rd_off(D0, 2, 1)>(vb), l3 = tr_read<v_rd_off(D0, 3, 0)>(vb), h3 = tr_read<v_rd_off(D0, 3, 1)>(vb);
    asm volatile("s_waitcnt lgkmcnt(0)" ::: "memory"); SBAR();
#define PK(L, H) (bf16x8){L[0], L[1], L[2], L[3], H[0], H[1], H[2], H[3]}
    od = __builtin_amdgcn_mfma_f32_32x32x16_bf16(pa0, PK(l0, h0), od, 0, 0, 0);
    od = __builtin_amdgcn_mfma_f32_32x32x16_bf16(pa1, PK(l1, h1), od, 0, 0, 0);
    od = __builtin_amdgcn_mfma_f32_32x32x16_bf16(pa2, PK(l2, h2), od, 0, 0, 0);
    od = __builtin_amdgcn_mfma_f32_32x32x16_bf16(pa3, PK(l3, h3), od, 0, 0, 0);
#undef PK
}
__device__ __forceinline__ void pv_d0(f32x16* o, int vb, bf16x8 pa0, bf16x8 pa1, bf16x8 pa2, bf16x8 pa3) {
    pv_one<0>(o[0], vb, pa0, pa1, pa2, pa3); pv_one<1>(o[1], vb, pa0, pa1, pa2, pa3); pv_one<2>(o[2], vb, pa0, pa1, pa2, pa3); pv_one<3>(o[3], vb, pa0, pa1, pa2, pa3);
}

__device__ __forceinline__ void attn_unit(const bf16_t* __restrict__ P, bf16_t* __restrict__ Y, int qrow0, int krow0, int nkeys, int h, float lam, float osc, const float* __restrict__ subln_g, char* lds, unsigned long long* g_ts, int wv0) {
    const int tid = opaque_tid(wv0), wid = tid >> 6, lane = tid & 63, r32 = lane & 31, hi = lane >> 5, rg = wid & 3, comp = wid >> 2;
    char* V_lds = lds + OFF_V; char* K_lds = lds + OFF_K;
    float* ws = (float*)(lds + OFF_WS) + wid * 64; float* li_l = ws; float* al_l = ws + 32;
    float m_reg = -1e30f, l_reg = 0; f32x16 o[4] = {}; bf16x8 qr[4];
    const bf16_t* Qw = P + (size_t)(qrow0 + rg * 32 + r32) * N_IN + C_Q + h * 128 + comp * 64 + hi * 8;
#pragma unroll
    for (int d0 = 0; d0 < 4; ++d0) qr[d0] = *reinterpret_cast<const bf16x8*>(Qw + d0 * 16);
    const bf16_t* Kh = P + (size_t)krow0 * N_IN + C_K + h * 128; const bf16_t* Vh = P + (size_t)krow0 * N_IN + C_V + h * 128;
    const int sr = tid >> 4, sc = (tid & 15) * 8, vst0 = v_st(sr, sc), vst1 = v_st(32 + sr, sc);
    const int vb0 = (int)(uintptr_t)V_lds + v_rd_base(lane);
    const int cbase = comp * 128;
    struct { bf16x8 vs0, vs1, ks0, ks1; } sr_[2];
#define SLOAD(i, k0) do { sr_[i].vs0 = *reinterpret_cast<const bf16x8*>(&Vh[(size_t)((k0) + sr) * N_IN + sc]); sr_[i].vs1 = *reinterpret_cast<const bf16x8*>(&Vh[(size_t)((k0) + 32 + sr) * N_IN + sc]); \
    sr_[i].ks0 = *reinterpret_cast<const bf16x8*>(&Kh[(size_t)((k0) + sr) * N_IN + sc]); sr_[i].ks1 = *reinterpret_cast<const bf16x8*>(&Kh[(size_t)((k0) + 32 + sr) * N_IN + sc]); } while (0)
#define SWRITE(b, i) do { *(bf16x8*)(V_lds + (b) * SHM_V + vst0) = sr_[i].vs0; *(bf16x8*)(V_lds + (b) * SHM_V + vst1) = sr_[i].vs1; const int kc = sc * 2; \
    *(bf16x8*)(K_lds + (b) * SHM_K + KSWZ(sr, kc)) = sr_[i].ks0; *(bf16x8*)(K_lds + (b) * SHM_K + KSWZ(32 + sr, kc)) = sr_[i].ks1; } while (0)
#define SWAIT() asm volatile("s_waitcnt vmcnt(4)" ::: "memory")
#define RESC(a) do { if (__any((a) < 1.f)) { if (hi == 0) al_l[r32] = (a); asm volatile("s_waitcnt lgkmcnt(0)" ::: "memory"); \
    _Pragma("unroll") for (int d = 0; d < 4; ++d) _Pragma("unroll") for (int r = 0; r < 16; ++r) o[d][r] *= al_l[crow(r, hi)]; } } while (0)
    f32x16 pA0, pA1, pB0, pB1; float mnA, mnB, alA, alB; bf16x8 pa0, pa1, pa2, pa3; const int NT = nkeys / KVBLK;
    constexpr int SE = 0, SO = 1;
    SLOAD(SE, 0); asm volatile("s_waitcnt vmcnt(0)" ::: "memory"); SWRITE(0, SE); __syncthreads();
    qkt(pA0, pA1, K_lds, qr, r32, hi, cbase); partialSM(pA0, pA1, m_reg, mnA, alA);
    SLOAD(SO, KVBLK); if (2 < NT) SLOAD(SE, 2 * KVBLK);
    SWAIT(); SWRITE(1, SO); __syncthreads();
    for (int j = 1; j + 1 < NT; j += 2) {
        SBAR(); qkt(pB0, pB1, K_lds + SHM_K, qr, r32, hi, cbase);
        finishSM(pA0, pA1, alA, l_reg, pa0, pa1, pa2, pa3); SBAR();
        SLOAD(SO, (j + 2) * KVBLK); SBAR();
        pv_d0(o, vb0, pa0, pa1, pa2, pa3); partialSM(pB0, pB1, m_reg, mnB, alB);
        __syncthreads(); SWAIT(); SWRITE(0, SE);
        RESC(alB); __syncthreads();
        SBAR(); qkt(pA0, pA1, K_lds, qr, r32, hi, cbase);
        finishSM(pB0, pB1, alB, l_reg, pa0, pa1, pa2, pa3); SBAR();
        if (j + 3 < NT) SLOAD(SE, (j + 3) * KVBLK); SBAR();
        pv_d0(o, vb0 + SHM_V, pa0, pa1, pa2, pa3); partialSM(pA0, pA1, m_reg, mnA, alA);
        __syncthreads(); SWAIT(); SWRITE(1, SO);
        RESC(alA); __syncthreads();
    }
    SBAR(); qkt(pB0, pB1, K_lds + SHM_K, qr, r32, hi, cbase);
    finishSM(pA0, pA1, alA, l_reg, pa0, pa1, pa2, pa3); SBAR();
    pv_d0(o, vb0, pa0, pa1, pa2, pa3); partialSM(pB0, pB1, m_reg, mnB, alB);
    __syncthreads(); RESC(alB);
    finishSM(pB0, pB1, alB, l_reg, pa0, pa1, pa2, pa3); SBAR();
    pv_d0(o, vb0 + SHM_V, pa0, pa1, pa2, pa3);
    if (hi == 0) li_l[r32] = l_reg; asm volatile("s_waitcnt lgkmcnt(0)" ::: "memory");
#pragma unroll
    for (int r = 0; r < 16; ++r) { const float rl = __builtin_amdgcn_rcpf(li_l[crow(r, hi)]);
#pragma unroll
        for (int d0 = 0; d0 < 4; ++d0) o[d0][r] *= rl; }
    __syncthreads();
    float* X = (float*)lds + (size_t)rg * 64 * 64 + lane;
    if (comp == 1) {
#pragma unroll
        for (int d0 = 0; d0 < 4; ++d0)
#pragma unroll
            for (int r = 0; r < 16; ++r) X[(d0 * 16 + r) * 64] = o[d0][r];
    }
    __syncthreads();
    if (comp == 0) {
        float rs[16];
#pragma unroll
        for (int r = 0; r < 16; ++r) { float ss = 0.f;
#pragma unroll
            for (int d0 = 0; d0 < 4; ++d0) { o[d0][r] -= lam * X[(d0 * 16 + r) * 64]; ss += o[d0][r] * o[d0][r]; }
#pragma unroll
            for (int x = 1; x < 32; x <<= 1) ss += __shfl_xor(ss, x);
            rs[r] = rsqrtf(ss * (1.f / 128.f) + EPS) * osc; }
#pragma unroll
        for (int d0 = 0; d0 < 4; ++d0) { const int col = d0 * 32 + r32; const float sg = subln_g[col];
#pragma unroll
            for (int r = 0; r < 16; ++r) { const size_t row = (size_t)(qrow0 + rg * 32 + crow(r, hi));
                const float g = bf2f(P[row * N_IN + C_GA + h * 128 + col]);
                Y[row * DM + h * 128 + col] = (bf16_t)f2bf(o[d0][r] * rs[r] * sg * silu_f(g)); } }
    }
    __syncthreads();
#undef SLOAD
#undef SWRITE
#undef SWAIT
#undef RESC
}
#undef KSWZ
#undef SBAR
}

namespace mixu {
constexpr int TT = 32;
constexpr int OFF_A = 0;
constexpr int OFF_B = 65536;
constexpr int AB_STRIDE = 1040;
struct Args { const bf16_t* P; bf16_t* Y; const bf16_t* wpool_t; const float* pool_scale; const float* w_dw; const float* b_dw; const float* ln_g; const float* ln_b; const bf16_t* wpw2_t; };
__device__ __forceinline__ float bflo(unsigned w) { return __uint_as_float(w << 16); }
__device__ __forceinline__ float bfhi(unsigned w) { return __uint_as_float(w & 0xffff0000u); }
__device__ __forceinline__ float ldsbf(const LAS unsigned char* p) { return bf2f(*(const LAS bf16_t*)p); }

__device__ __forceinline__ void wave_sum4(float (&v)[4]) {
#pragma unroll
    for (int o = 1; o < 64; o <<= 1) {
#pragma unroll
        for (int q = 0; q < 4; ++q) v[q] += __shfl_xor(v[q], o); }
}
__device__ __forceinline__ void mix_unit(const Args& a, int row0, LAS unsigned char* lds, unsigned long long* g_ts, int wv0) {
    const int tid = opaque_tid(wv0), wid = __builtin_amdgcn_readfirstlane(tid >> 6), lane = tid & 63, fr = lane & 15, fq = lane >> 4;
    const int b = row0 / TPB, t0 = row0 % TPB; const bool isctx = t0 < CTX;
    const int seq0 = b * TPB + (isctx ? 0 : CTX), L = isctx ? CTX : SEQ, tl0 = isctx ? t0 : t0 - CTX;
    LAS unsigned char* rA = lds + OFF_A; LAS unsigned char* rB = lds + OFF_B; LAS float* ys = (LAS float*)rB;
    const bf16_t* P = a.P;
    const int g = wid >> 1, nh = wid & 1;
    STAMPI(59);
    bf16x8 bfr[4][4]; u32x2 gwp[4][2]; f32x4 ps[4]; float w[31];
    { const bf16_t* wt = a.wpool_t + (size_t)g * 128 * 128 + (size_t)(nh * 4) * 4 * 512 + lane * 8;
#pragma unroll
      for (int nb = 0; nb < 4; ++nb) {
#pragma unroll
          for (int ks = 0; ks < 4; ++ks) bfr[nb][ks] = *(const bf16x8*)(wt + (nb * 4 + ks) * 512); } }
#pragma unroll
    for (int j = 0; j < 31; ++j) w[j] = a.w_dw[j * 512 + tid];
    const float bias = a.b_dw[tid];
#pragma unroll 1
    for (int i = 0; i < 14; ++i) {
        const bool up = i < 6; const int p = (up ? i : i - 6) * 8 + wid, tl = tl0 - (up ? 8 : 15) + p;
        LAS unsigned char* dst = (up ? rB : rA) + p * 1024;
        if (up || p < TT + 30) {
            if (tl >= 0 && tl < L) __builtin_amdgcn_global_load_lds((const unsigned*)(P + (size_t)(seq0 + tl) * N_IN + (up ? C_UP : C_CA) + lane * 8), (LAS unsigned*)dst, 16, 0, 0);
            else { unsigned z = 0u; asm volatile("" : "+v"(z)); *(LAS u32x4*)(dst + lane * 16) = (u32x4){z, z, z, z}; }
        }
    }
    STAMPI(60);
    asm volatile("s_waitcnt vmcnt(0)" ::: "memory");
    __syncthreads();
    STAMPI(61);
#pragma unroll
    for (int nb = 0; nb < 4; ++nb) { const int n = g * 128 + nh * 64 + nb * 16 + fq * 4; ps[nb] = *(const f32x4*)(a.pool_scale + n);
#pragma unroll
        for (int m = 0; m < 2; ++m) gwp[nb][m] = *(const u32x2*)(P + ((size_t)row0 + m * 16 + fr) * N_IN + C_GP + n); }
    { const int HW = 1 << (wid >> 1); LAS unsigned char* col = rB + tid * 2; float s = 0.f;
      for (int p = 0; p < 2 * HW; ++p) s += ldsbf(col + (8 - HW + p) * 1024);
#pragma unroll 8
      for (int tk = 0; tk < TT; ++tk) { const int tl = tl0 + tk, lo = max(tl - HW, 0), hi = min(tl + HW, L);
          const float d = s * __builtin_amdgcn_rcpf((float)(hi - lo)) - ldsbf(col + (8 + tk) * 1024);
          s += ldsbf(col + (8 + HW + tk) * 1024) - ldsbf(col + (8 - HW + tk) * 1024);
          *(LAS bf16_t*)(col + tk * 1024) = (bf16_t)f2bf(d); } }
    __syncthreads();
    STAMPI(62);
    { bf16x8 af[2][4];
#pragma unroll
      for (int m = 0; m < 2; ++m)
#pragma unroll
          for (int ks = 0; ks < 4; ++ks) af[m][ks] = *(const LAS bf16x8*)(rB + (m * 16 + fr) * 1024 + (g * 128 + ks * 32 + fq * 8) * 2);
#pragma unroll
      for (int nb = 0; nb < 4; ++nb) { const int n = g * 128 + nh * 64 + nb * 16 + fq * 4;
#pragma unroll
          for (int m = 0; m < 2; ++m) { f32x4 acc = {0.f, 0.f, 0.f, 0.f};
#pragma unroll
              for (int ks = 0; ks < 4; ++ks) acc = __builtin_amdgcn_mfma_f32_16x16x32_bf16(bfr[nb][ks], af[m][ks], acc, 0, 0, 0);
              const f32x4 v = acc * ps[nb]; const u32x2 gw = gwp[nb][m];
              u32x2 o; o.x = pk2(v[0] * silu_f(bflo(gw.x)), v[1] * silu_f(bfhi(gw.x))); o.y = pk2(v[2] * silu_f(bflo(gw.y)), v[3] * silu_f(bfhi(gw.y)));
              *(u32x2*)(a.Y + ((size_t)row0 + m * 16 + fr) * DM + 1024 + n) = o; } } }
    const bf16_t* wt2 = a.wpw2_t + (size_t)(wid * 4) * 16 * 512 + lane * 8;
    bf16x8 bcur[16], bnxt[16]; u32x2 gcur[2];
#pragma unroll
    for (int ks = 0; ks < 16; ++ks) bcur[ks] = *(const bf16x8*)(wt2 + ks * 512);
    __syncthreads();
    STAMPI(63);
    { const LAS unsigned char* ucol = rA + tid * 2; float win[34];
#pragma unroll
      for (int i = 0; i < 30; ++i) win[i] = ldsbf(ucol + i * 1024);
#pragma unroll 1
      for (int it = 0; it < TT / 4; ++it) {
#pragma unroll
          for (int k = 0; k < 4; ++k) win[30 + k] = ldsbf(ucol + (30 + 4 * it + k) * 1024);
#pragma unroll
          for (int k = 0; k < 4; ++k) { float y = bias;
#pragma unroll
              for (int j = 0; j < 31; ++j) y += win[k + j] * w[j];
              ys[(4 * it + k) * 512 + tid] = y; }
#pragma unroll
          for (int i = 0; i < 30; ++i) win[i] = win[i + 4];
      } }
    __syncthreads();
    STAMPI(64);
    { float v[4][8], s[4], qq[4];
#pragma unroll
      for (int q = 0; q < 4; ++q) { s[q] = 0.f;
#pragma unroll
          for (int j = 0; j < 8; ++j) { v[q][j] = ys[(wid * 4 + q) * 512 + lane + 64 * j]; s[q] += v[q][j]; } }
      wave_sum4(s);
#pragma unroll
      for (int q = 0; q < 4; ++q) { const float mu = s[q] * (1.f / 512.f); qq[q] = 0.f;
#pragma unroll
          for (int j = 0; j < 8; ++j) { v[q][j] -= mu; qq[q] += v[q][j] * v[q][j]; } }
      wave_sum4(qq);
#pragma unroll
      for (int j = 0; j < 8; ++j) { const int c = lane + 64 * j; const float lg = a.ln_g[c], lb = a.ln_b[c];
#pragma unroll
          for (int q = 0; q < 4; ++q) { const float rs = rsqrtf(qq[q] * (1.f / 512.f) + EPS), z = v[q][j] * rs * lg + lb;
              *(LAS bf16_t*)(rA + (wid * 4 + q) * AB_STRIDE + c * 2) = (bf16_t)f2bf(silu_f(z)); } } }
    __syncthreads();
    STAMPI(65);
#pragma unroll 1
    for (int nb = 0; nb < 4; ++nb) {
        const int nn = min(nb + 1, 3);
#pragma unroll
        for (int ks = 0; ks < 16; ++ks) bnxt[ks] = *(const bf16x8*)(wt2 + (nn * 16 + ks) * 512);
        const int n = wid * 64 + nb * 16 + fq * 4;
#pragma unroll
        for (int m = 0; m < 2; ++m) gcur[m] = *(const u32x2*)(P + ((size_t)row0 + m * 16 + fr) * N_IN + C_GC + n);
        f32x4 acc[2] = {(f32x4){0.f, 0.f, 0.f, 0.f}, (f32x4){0.f, 0.f, 0.f, 0.f}};
#pragma unroll
        for (int ks = 0; ks < 16; ++ks)
#pragma unroll
            for (int m = 0; m < 2; ++m) { const bf16x8 af = *(const LAS bf16x8*)(rA + (m * 16 + fr) * AB_STRIDE + (ks * 32 + fq * 8) * 2);
                acc[m] = __builtin_amdgcn_mfma_f32_16x16x32_bf16(bcur[ks], af, acc[m], 0, 0, 0); }
#pragma unroll
        for (int m = 0; m < 2; ++m) { const f32x4 v = acc[m];
            u32x2 o; o.x = pk2(v[0] * silu_f(bflo(gcur[m].x)), v[1] * silu_f(bfhi(gcur[m].x))); o.y = pk2(v[2] * silu_f(bflo(gcur[m].y)), v[3] * silu_f(bfhi(gcur[m].y)));
            *(u32x2*)(a.Y + ((size_t)row0 + m * 16 + fr) * DM + 1536 + n) = o; }
#pragma unroll
        for (int ks = 0; ks < 16; ++ks) bcur[ks] = bnxt[ks];
    }
    __syncthreads();
    STAMPI(66);
}
}

#define XB_TMO      128
#define XB_XCNT(j)  (256  + 64 * (j))
#define XB_XSUB(j)  (1280 + 64 * (j))
#define XB_XGEN(j)  (2304 + 64 * (j))
#define XB_TOP      3328
#define XB_TOPGEN   3392
#define XCD_BAR_WORDS 3456
#define XB_SPIN_CAP (1u << 18)
__device__ __forceinline__ unsigned xb_ld(unsigned* p)              { return __hip_atomic_load(p, __ATOMIC_RELAXED, __HIP_MEMORY_SCOPE_AGENT); }
__device__ __forceinline__ unsigned xb_add(unsigned* p, unsigned v) { return __hip_atomic_fetch_add(p, v, __ATOMIC_RELAXED, __HIP_MEMORY_SCOPE_AGENT); }
__device__ __forceinline__ unsigned xb_xcc_id() { return (unsigned)__builtin_amdgcn_s_getreg((3 << 11) | 20) & 0xFu; }
#define XB_SPIN(cond, bar) do { unsigned _sp = 0; while (cond) { __builtin_amdgcn_s_sleep(1); \
    if ((++_sp & 255u) == 0u) { if (xb_ld(&(bar)[XB_TMO])) break; if (_sp > XB_SPIN_CAP) { atomicAdd(&(bar)[XB_TMO], 1u); break; } } } } while (0)
struct XcdBarrier { unsigned* bar; unsigned x; volatile LAS unsigned* st; };
__device__ __forceinline__ XcdBarrier xcd_barrier_post(unsigned* bar, volatile LAS unsigned* st) {
    XcdBarrier b; b.bar = bar; b.x = xb_xcc_id(); b.st = st;
    if (threadIdx.x == 0) (void)xb_add(&bar[XB_XCNT(b.x)], 1u);
    return b;
}
__device__ __forceinline__ void xcd_barrier_complete(unsigned* bar, unsigned x, unsigned& nloc, unsigned& nx) {
    const unsigned G = gridDim.x * gridDim.y * gridDim.z;
    unsigned sum, cnt, mine, sp = 0u;
    for (;;) {
        sum = 0u; cnt = 0u; mine = 0u;
#pragma unroll
        for (unsigned j = 0; j < 16; ++j) { const unsigned c = xb_ld(&bar[XB_XCNT(j)]); sum += c; cnt += (c > 0u) ? 1u : 0u; mine = (j == x) ? c : mine; }
        if (sum == G) break;
        __builtin_amdgcn_s_sleep(1);
        if ((++sp & 255u) == 0u) { if (xb_ld(&bar[XB_TMO])) break; if (sp > XB_SPIN_CAP) { atomicAdd(&bar[XB_TMO], 1u); break; } }
    }
    nloc = mine > 0u ? mine : 1u; nx = cnt > 0u ? cnt : 1u;
}
__device__ __forceinline__ void xcd_barrier(const XcdBarrier& b, int wv0) {
    asm volatile("s_waitcnt vmcnt(0)" ::: "memory");
    __syncthreads();
    if (wv0 == 0 && lane_id() == 0) {
        unsigned* bar = b.bar;
        __builtin_amdgcn_s_waitcnt(0);
        unsigned nloc = b.st[0], nx = b.st[1];
        if (nloc == 0u) { xcd_barrier_complete(bar, b.x, nloc, nx); b.st[0] = nloc; b.st[1] = nx; }
        const unsigned old = xb_add(&bar[XB_XSUB(b.x)], 1u);
        const unsigned gen = old / nloc;
        if (old + 1u == (gen + 1u) * nloc) {
            __builtin_amdgcn_fence(__ATOMIC_RELEASE, "agent");
            asm volatile("s_waitcnt vmcnt(0)" ::: "memory");
            const unsigned og = xb_add(&bar[XB_TOP], 1u);
            const unsigned tg = og / nx;
            if (og + 1u == (tg + 1u) * nx) xb_add(&bar[XB_TOPGEN], 1u);
            else XB_SPIN(xb_ld(&bar[XB_TOPGEN]) == tg, bar);
            __builtin_amdgcn_fence(__ATOMIC_ACQUIRE, "agent");
            xb_add(&bar[XB_XGEN(b.x)], 1u);
            asm volatile("s_waitcnt vmcnt(0)" ::: "memory");
        } else {
            XB_SPIN(xb_ld(&bar[XB_XGEN(b.x)]) == gen, bar);
            __builtin_amdgcn_fence(__ATOMIC_ACQUIRE, "agent");
            asm volatile("s_waitcnt vmcnt(0)" ::: "memory");
        }
    }
    __syncthreads();
}

__device__ __forceinline__ int win_dest_row(int n) { if (n < C_CA || n >= C_GC) return n; const int isb = n >= C_CB ? 1 : 0, c = n - (isb ? C_CB : C_CA); return C_CA + (c >> 4) * 32 + (isb << 4) + (c & 15); }
__device__ __forceinline__ size_t frag_off(int n, int k, int nks) { return ((size_t)(((n >> 6) * 4 + ((n >> 4) & 3)) * nks + (k >> 5)) * 64 + ((k >> 3) & 3) * 16 + (n & 15)) * 8; }
template <int MODE  , int K, int N> __device__ __forceinline__ void p0_transpose_item(const float* W, bf16_t* WT, LAS float* scr, int item, int lane) {
    const int nblk = N / 32, kb = item / nblk, nb = item % nblk, k0 = 64 * kb, n0 = 32 * nb;
    float tv[32];
    const float* Wp = W + (size_t)(k0 + (lane >> 5)) * N + n0 + (lane & 31);
#pragma unroll
    for (int i = 0; i < 32; ++i) tv[i] = Wp[(size_t)(2 * i) * N];
#pragma unroll
    for (int i = 0; i < 32; ++i) scr[(2 * i + (lane >> 5)) * 33 + (lane & 31)] = tv[i];
    asm volatile("s_waitcnt lgkmcnt(0)" ::: "memory");
    const int c = lane & 7;
#pragma unroll
    for (int j = 0; j < 4; ++j) { const int n = (lane >> 3) + 8 * j; const LAS float* s = scr + (8 * c) * 33 + n;
        u32x4 o; o.x = pk2(s[0 * 33], s[1 * 33]); o.y = pk2(s[2 * 33], s[3 * 33]); o.z = pk2(s[4 * 33], s[5 * 33]); o.w = pk2(s[6 * 33], s[7 * 33]);
        if (MODE == 2) *(u32x4*)(WT + frag_off(n0 + n, k0 + 8 * c, K / 32)) = o;
        else *(u32x4*)(WT + (size_t)(MODE == 1 ? win_dest_row(n0 + n) : n0 + n) * K + k0 + 8 * c) = o; }
    asm volatile("s_waitcnt lgkmcnt(0)" ::: "memory");
}

struct Args {
    const float* in[22]; float* out; unsigned char* ws; int ph_lo, ph_hi;
};

__device__ __forceinline__ void norm_row(const float* __restrict__ xsrc, const float* __restrict__ csrc, int cslices, const float* __restrict__ g, const float* __restrict__ MODl, bf16_t* __restrict__ H, int row, int lane) {
    const int b = row / TPB, t = row % TPB; const bool isctx = t < CTX;
    const float* src = isctx ? csrc + ((size_t)b * CTX + t) * DM : xsrc + ((size_t)b * SEQ + (t - CTX)) * DM;
    const float* mod = MODl + (size_t)(isctx ? 4 : b) * N_MOD;
    f32x4 v[8]; float ss = 0.f;
#pragma unroll
    for (int j = 0; j < 8; ++j) { v[j] = ((const f32x4*)src)[lane + 64 * j];
        if (isctx) for (int sl = 1; sl < cslices; ++sl) v[j] += ((const f32x4*)(src + (size_t)sl * (BATCH * CTX * DM)))[lane + 64 * j];
        ss += (v[j][0] * v[j][0] + v[j][1] * v[j][1]) + (v[j][2] * v[j][2] + v[j][3] * v[j][3]); }
    ss = wave_sum(ss);
    const float rstd = rsqrtf(ss * (1.f / DM) + EPS);
#pragma unroll
    for (int j = 0; j < 8; ++j) { const int col = (lane + 64 * j) * 4;
        const f32x4 gg = *(const f32x4*)(g + col), sh = *(const f32x4*)(mod + col), sc = *(const f32x4*)(mod + 2048 + col);
        const f32x4 o = v[j] * rstd * gg * (sc + 1.f) + sh;
        u32x2 w; w.x = pk2(o[0], o[1]); w.y = pk2(o[2], o[3]);
        *(u32x2*)(H + (size_t)row * DM + col) = w; }
}

__global__ void __launch_bounds__(NTHREADS, 2) mega_fwd(Args args) {
    extern __shared__ __attribute__((aligned(16))) unsigned char lds_raw[];
    LAS unsigned char* lds = (LAS unsigned char*)lds_raw;
    const int wv0 = __builtin_amdgcn_readfirstlane(threadIdx.x >> 6);
    const int G = gridDim.x, bx = blockIdx.x; const int vcu = (G % 8 == 0) ? (bx % 8) * (G / 8) + bx / 8 : bx;
    unsigned char* ws = args.ws;
    unsigned* ctl = (unsigned*)(ws + WS_CTL);
    unsigned long long* g_ts = (unsigned long long*)(ws + WS_CTL + 32768); (void)g_ts;
    STAMP(0);
    const float* x = args.in[0]; const float* c_in = args.in[1]; const float* ctx = args.in[2]; const float* c_ctx = args.in[3];
    const float* w_mod = args.in[4]; const float* b_mod = args.in[5]; const float* norm_g = args.in[6]; const float* w_in = args.in[7];
    const float* subln_g = args.in[12]; const float* w_pool = args.in[13]; const float* pool_scale = args.in[14]; const float* w_dw = args.in[15];
    const float* b_dw = args.in[16]; const float* ln_g = args.in[17]; const float* ln_b = args.in[18]; const float* w_pw2 = args.in[19];
    const float* w_out = args.in[20]; const float* final_g = args.in[21];
    float* out = args.out;
    float* ROPE = (float*)(ws + WS_ROPE); float* MOD = (float*)(ws + WS_MOD);
    bf16_t* WIN = (bf16_t*)(ws + WS_WIN); bf16_t* WOUT = (bf16_t*)(ws + WS_WOUT); bf16_t* WPW2 = (bf16_t*)(ws + WS_WPW2); bf16_t* WPOOL = (bf16_t*)(ws + WS_WPOOL);
    float* CTXS = (float*)(ws + WS_CTXS); bf16_t* H = (bf16_t*)(ws + WS_H); bf16_t* P = (bf16_t*)(ws + WS_P); bf16_t* Y = (bf16_t*)(ws + WS_YMIX);

#if MK_USE_CG
    cg::grid_group grid = cg::this_grid();
#define SEAM() do { __syncthreads(); grid.sync(); } while (0)
#else
#if MK_COOP
    if (args.ph_lo < 0) cg::this_grid().sync();
#endif
    for (int u = threadIdx.x; u < (LDS_BYTES - LDSCTL_OFF) / 4; u += NTHREADS) ((LAS unsigned*)(lds + LDSCTL_OFF))[u] = 0u;
    __syncthreads();
    XcdBarrier bar = xcd_barrier_post(ctl + CW_BAR, (volatile LAS unsigned*)(lds + MISC_OFF) + 8);
#define SEAM() xcd_barrier(bar, wv0)
#endif
    const int NGW = G * NWAVES;
#define PHASE_IDS() const int tid = opaque_tid(wv0), lane = tid & 63, wave = __builtin_amdgcn_readfirstlane(tid >> 6), gw = vcu * NWAVES + wave; (void)gw; (void)lane
    constexpr int NMODI = 2 * (DM / 256) * (N_MOD / 256);
    constexpr int I_WIN = (DM / 64) * (N_IN / 32), I_WOUT = (DM / 64) * (DM / 32), I_PW2 = (512 / 64) * (512 / 32), I_POOL = 4 * (128 / 64) * (128 / 32);
    constexpr int TR_A = I_WIN + I_PW2 + I_POOL, TR_B = TR_A + I_WOUT, TR_END = TR_B + I_WIN + I_WOUT + I_PW2 + I_POOL;
    static_assert(TR_A % 8 == 0 && TR_B % 8 == 0 && TR_END % 8 == 0, "transpose ranges are whole block-items");

#pragma unroll 1
    for (int ph = args.ph_lo; ph < args.ph_hi; ++ph) {
        const int l = ph == 0 ? 0 : (ph - 1) >> 2, kind = ph == 0 ? 0 : (ph == 9 ? 5 : 1 + ((ph - 1) & 3));
        const float* MODl = MOD + (size_t)l * 5 * N_MOD;
        const float* xsrc = l == 0 ? x : out; const float* csrc = l == 0 ? ctx : CTXS;
        const bool last = (l == DEPTH - 1);
        STAMP(2 * ph);
        if (kind == 1) {
            PHASE_IDS();
            for (int rep = 0; rep < REP_NORM; ++rep)
            for (int row = gw; row < M_TOT; row += NGW) norm_row(xsrc, csrc, l == 0 ? 1 : 4, norm_g + l * DM, MODl, H, row, lane);
        }
        if (kind == 2) {
            pg8::Gemm g{H, WIN + (size_t)l * DM * N_IN, M_TOT, N_IN, DM, DM};
            const int Gg = (!last && G == 256) ? 240 : G;
            pg8::TileSched S; if (!last) S.init(36, N_IN / 256, 0, 0, Gg, bx); else S.init(32, N_IN / 256, 32, 1, G, bx);
            pg8::EpiIn E{P, ROPE};
            if (bx < Gg)
            for (int rep = 0; rep < REP_INPROJ; ++rep)
            pg8::gemm_phase<pg8::EpiIn, pg8::TileSched, true, true>(lds, g, S, E, wv0);
        }
        if (kind == 3) {
            const float lam_init = l == 0 ? 0.2f : 0.35550906f;
            const float lam = __uint_as_float(__builtin_amdgcn_readfirstlane(__float_as_uint(MOD[2 * 5 * N_MOD + l]))), osc = 1.f - lam_init;
            { mixu::Args ma{P, Y, WPOOL + (size_t)l * 4 * 128 * 128, pool_scale + l * 512, w_dw + (size_t)l * 31 * 512, b_dw + l * 512, ln_g + l * 512, ln_b + l * 512, WPW2 + (size_t)l * 512 * 512};
              const int ntiles = last ? BATCH * SEQ / 32 : M_TOT / 32;
              for (int rep = 0; rep < REP_MIX; ++rep)
              for (int t = vcu; t < ntiles; t += G) { int row0;
                  if (last) row0 = (t / 64) * TPB + CTX + (t % 64) * 32; else row0 = t * 32;
                  mixu::mix_unit(ma, row0, lds, g_ts, wv0); } }
            STAMP(40 + l);
            { constexpr int NUL = BATCH * HEADS * (SEQ / 128), NUC = BATCH * HEADS * (CTX / 128); const int upc = (NUL + G - 1) / G, ncx = last ? 0 : (NUC + G - 1) / G;
              for (int rep = 0; rep < REP_ATT; ++rep)
              for (int i = 0; i < upc + ncx; ++i) {
                  int qrow0, krow0, nkeys, h;
                  if (i < upc) { const int id = vcu * upc + i; if (id >= NUL) continue;
                      const int bh = id / (SEQ / 128), qb = id % (SEQ / 128), b = bh / HEADS; h = bh % HEADS; qrow0 = b * TPB + CTX + qb * 128; krow0 = b * TPB; nkeys = TPB; }
                  else { const int id = (G == 256 ? vcu - 32 : vcu) + (i - upc) * G; if (id < 0 || id >= NUC) continue;
                      const int bh = id / (CTX / 128), qb = id % (CTX / 128), b = bh / HEADS; h = bh % HEADS; qrow0 = b * TPB + qb * 128; krow0 = b * TPB; nkeys = CTX; }
                  att::attn_unit(P, Y, qrow0, krow0, nkeys, h, lam, osc, subln_g + l * 128, (char*)lds_raw, g_ts, wv0); } }
        }
        if (kind == 4) {
            pg8::Gemm g{Y, WOUT + (size_t)l * DM * DM, M_TOT, DM, DM, DM};
            pg8::TileSched S; S.init(32, DM / 256, 0, 1, G, bx);
            pg8::EpiOut E{xsrc, csrc, out, CTXS, MODl};
            for (int rep = 0; rep < (last ? 1 : REP_OUT); ++rep)
            pg8::gemm_phase<pg8::EpiOut, pg8::TileSched, true, true>(lds, g, S, E, wv0);
            if (!last) {
                pg8::Gemm gc{Y, WOUT + (size_t)l * DM * DM, M_TOT, DM, DM / 4, DM};
                pg8::TileSched Sc; Sc.init(0, DM / 256, 128, 0, G, bx, 1);
                pg8::gemm_phase<pg8::EpiOut, pg8::TileSched, true, true>(lds, gc, Sc, E, wv0);
            }
        }
        if (kind == 5) {
            PHASE_IDS();
            for (int row = gw; row < BATCH * SEQ; row += NGW) {
                f32x4* p = (f32x4*)(out + (size_t)row * DM); f32x4 v[8]; float ss = 0.f;
#pragma unroll
                for (int j = 0; j < 8; ++j) { v[j] = p[lane + 64 * j]; ss += (v[j][0] * v[j][0] + v[j][1] * v[j][1]) + (v[j][2] * v[j][2] + v[j][3] * v[j][3]); }
                const float rstd = rsqrtf(wave_sum(ss) * (1.f / DM) + EPS);
#pragma unroll
                for (int j = 0; j < 8; ++j) { const f32x4 gg = *(const f32x4*)(final_g + (lane + 64 * j) * 4); p[lane + 64 * j] = v[j] * rstd * gg; }
            }
        }
        {
          constexpr int ND1 = (TR_B - TR_A) / 8 + I_WIN / 8, ND2 = NMODI / 2 + (TR_END - TR_B - I_WIN) / 8;
          const int steal = (ph == 2) ? 1 : (ph == 4 ? 2 : 0);
          if (ph <= 1 || steal) {
              PHASE_IDS();
              LAS int* jbox = (LAS int*)(lds + LDSCTL_OFF + 64);
              for (int rep = 0; rep < (ph == 0 ? REP_P0 : 1); ++rep)
              for (int j = bx; ; j += G) {
                  if (steal) { __syncthreads(); if (tid == 0) *jbox = (int)__hip_atomic_fetch_add(ctl + CW_STEAL + 64 * (steal - 1), 1u, __ATOMIC_RELAXED, __HIP_MEMORY_SCOPE_AGENT); __syncthreads(); j = *jbox; if (j >= (steal == 1 ? ND1 : ND2)) break; }
                  else if (j >= (ph == 0 ? NMODI / 2 + 1 : TR_A / 8)) break;
                  int it;
                  if (ph == 0) it = j < NMODI / 2 ? j : NMODI;
                  else if (ph == 1) it = NMODI + 1 + j;
                  else if (steal == 1) it = NMODI + 1 + TR_A / 8 + j;
                  else it = j < NMODI / 2 ? NMODI / 2 + j : NMODI + 1 + (TR_B + I_WIN) / 8 + (j - NMODI / 2);
                  for (int irep = 0; irep < (ph != 0 ? 1 : (it < NMODI ? REP_P0M : (it == NMODI ? 1 : REP_P0T))); ++irep)
                  if (it < NMODI) {
                      const int lm = it / (NMODI / 2), rem = it % (NMODI / 2), kg = rem / 24, cg = rem % 24, c4 = cg * 256 + lane * 4;
                      LAS float* sv = (LAS float*)lds; LAS f32x4* red = (LAS f32x4*)(lds + 8192);
                      __syncthreads();
                      for (int i = tid; i < 5 * 256; i += NTHREADS) { const int r = i >> 8, k = kg * 256 + (i & 255); const float v = r < 4 ? c_in[r * 2048 + k] : c_ctx[k]; sv[i] = v / (1.f + expf(-v)); }
                      __syncthreads();
                      f32x4 acc[5];
#pragma unroll
                      for (int r = 0; r < 5; ++r) acc[r] = (f32x4){0.f, 0.f, 0.f, 0.f};
                      const float* W = w_mod + (size_t)lm * DM * N_MOD + (size_t)(kg * 256 + wave * 32) * N_MOD + c4;
#pragma unroll 16
                      for (int k = 0; k < 32; ++k) { const f32x4 w = *(const f32x4*)(W + (size_t)k * N_MOD);
#pragma unroll
                          for (int r = 0; r < 5; ++r) acc[r] += w * sv[r * 256 + wave * 32 + k]; }
#pragma unroll
                      for (int r = 0; r < 5; ++r) red[(wave * 5 + r) * 64 + lane] = acc[r];
                      __syncthreads();
                      if (tid < 320 && irep == 0) { const int r = tid >> 6, ln = tid & 63; f32x4 v = red[r * 64 + ln];
#pragma unroll
                          for (int w8 = 1; w8 < 8; ++w8) v += red[(w8 * 5 + r) * 64 + ln];
                          if (kg == 0) v += *(const f32x4*)(b_mod + lm * N_MOD + cg * 256 + ln * 4);
                          float* dst = MOD + ((size_t)lm * 5 + r) * N_MOD + cg * 256 + ln * 4;
#pragma unroll
                          for (int e = 0; e < 4; ++e) __hip_atomic_fetch_add(dst + e, v[e], __ATOMIC_RELAXED, __HIP_MEMORY_SCOPE_AGENT); }
                      __syncthreads();
                  } else if (it == NMODI) {
                      for (int i = tid; i < 64 * 16; i += NTHREADS) { const int pos = i >> 4, fi = i & 15; const float inv = powf(10000.f, -(float)fi / 16.f), ang = (float)pos * inv;
                          ROPE[i * 2] = cosf(ang); ROPE[i * 2 + 1] = sinf(ang); }
                      if (tid < 2) { const int ll = tid; float a = 0.f, b = 0.f;
                          for (int i = 0; i < 64; ++i) { a += args.in[8][ll * 64 + i] * args.in[9][ll * 64 + i]; b += args.in[10][ll * 64 + i] * args.in[11][ll * 64 + i]; }
                          const float lam_init = 0.8f - 0.6f * expf(-0.3f * (float)ll);
                          MOD[2 * 5 * N_MOD + ll] = expf(a) - expf(b) + lam_init; }
                  } else {
                      LAS float* scr = (LAS float*)(lds + wave * 16384);
                      int r = (it - NMODI - 1) * 8 + wave;
                      int lw = 0; if (r >= TR_B) { lw = 1; r -= TR_B; } else if (r >= TR_A) { r = r - TR_A + I_WIN; } else if (r >= I_WIN) { r = r - I_WIN + I_WIN + I_WOUT; }
                      if (r < I_WIN) p0_transpose_item<1, DM, N_IN>(w_in + (size_t)lw * DM * N_IN, WIN + (size_t)lw * DM * N_IN, scr, r, lane);
                      else if ((r -= I_WIN) < I_WOUT) p0_transpose_item<0, DM, DM>(w_out + (size_t)lw * DM * DM, WOUT + (size_t)lw * DM * DM, scr, r, lane);
                      else if ((r -= I_WOUT) < I_PW2) p0_transpose_item<2, 512, 512>(w_pw2 + (size_t)lw * 512 * 512, WPW2 + (size_t)lw * 512 * 512, scr, r, lane);
                      else { r -= I_PW2; p0_transpose_item<2, 128, 128>(w_pool + (size_t)(lw * 4 + r / 8) * 128 * 128, WPOOL + (size_t)(lw * 4 + r / 8) * 128 * 128, scr, r % 8, lane); }
                  }
              }
          }
        }
        STAMP(2 * ph + 1);
        if (ph + 1 < args.ph_hi) SEAM();
    }
#if MK_PROBE
    STAMP(50);
    if (blockIdx.x == 0 && wv0 == 0 && lane_id() == 0) { const unsigned long long dt = (g_ts[PROBE_X1] - g_ts[PROBE_X0]) * PROBE_AMP, t0 = __builtin_amdgcn_s_memrealtime();
        while (__builtin_amdgcn_s_memrealtime() - t0 < dt) __builtin_amdgcn_s_sleep(8); }
#endif
#undef SEAM
}

extern "C" void kernel_launch(void* const* d_in, const int* in_sizes, int n_in, void* d_out, int out_size, void* d_ws, size_t ws_size, hipStream_t stream) {
    static int grid = 0;
    if (grid == 0) {
        if (n_in != 22 || ws_size < WS_END || out_size != BATCH * SEQ * DM) { fprintf(stderr, "kernel_launch: unexpected n_in %d / out %d / ws %zu\n", n_in, out_size, ws_size); grid = -1; return; }
        int dev = 0, cus = 0, per_cu = 0;
        if (hipGetDevice(&dev) != hipSuccess || hipDeviceGetAttribute(&cus, hipDeviceAttributeMultiprocessorCount, dev) != hipSuccess) { grid = -1; return; }
        if (hipFuncSetAttribute((const void*)mega_fwd, hipFuncAttributeMaxDynamicSharedMemorySize, LDS_BYTES) != hipSuccess) { fprintf(stderr, "kernel_launch: hipFuncSetAttribute failed\n"); grid = -1; return; }
        if (hipOccupancyMaxActiveBlocksPerMultiprocessor(&per_cu, (const void*)mega_fwd, NTHREADS, LDS_BYTES) != hipSuccess || per_cu < 1) { fprintf(stderr, "kernel_launch: occupancy query says %d blocks per CU\n", per_cu); grid = -1; return; }
        (void)hipGetLastError();
        grid = cus;
    }
    if (grid < 0) return;
    (void)hipMemsetAsync((char*)d_ws + WS_CTL, 0, CTL_ZERO_BYTES, stream);
    Args a{};
    for (int i = 0; i < 22; ++i) a.in[i] = (const float*)d_in[i];
    a.out = (float*)d_out; a.ws = (unsigned char*)d_ws;
#if MK_PER_PHASE
    for (int ph = 0; ph < 10; ++ph) { a.ph_lo = ph; a.ph_hi = ph + 1;
        void* kargs[] = {&a};
        hipError_t e = hipLaunchCooperativeKernel((void*)mega_fwd, dim3(grid), dim3(NTHREADS), kargs, LDS_BYTES, stream);
        if (e != hipSuccess) { fprintf(stderr, "kernel_launch: launch failed: %s\n", hipGetErrorString(e)); break; } }
#else
    a.ph_lo = 0; a.ph_hi = 10;
#if MK_COOP
    void* kargs[] = {&a};
    hipError_t e = hipLaunchCooperativeKernel((void*)mega_fwd, dim3(grid), dim3(NTHREADS), kargs, LDS_BYTES, stream);
#else
    hipLaunchKernelGGL(mega_fwd, dim3(grid), dim3(NTHREADS), LDS_BYTES, stream, a);
    hipError_t e = hipPeekAtLastError();
#endif
    if (e != hipSuccess) fprintf(stderr, "kernel_launch: launch failed: %s (grid %d)\n", hipGetErrorString(e), grid);
#endif
}
```
